# Optimizing an MI355X kernel written in HIP

```python
import jax, jax.numpy as jnp
from jax import lax
import numpy as np

D_MODEL = 2048
BATCH = 4
SEQ = 4096
DEPTH = 2

GRID_W = 64
N_MEM = 256
HEAD_DIM = 128
N_Q_HEADS = D_MODEL // HEAD_DIM
N_KV_HEADS = N_Q_HEADS // 4
GROUP = N_Q_HEADS // N_KV_HEADS
ATTN_W = N_Q_HEADS * HEAD_DIM
KV_W = N_KV_HEADS * HEAD_DIM
ROPE_HALF = HEAD_DIM // 2
ROPE_THETA = 10000.0
Q_BLOCK = 128
D_RNN = D_MODEL
N_RNN_BLOCKS = 16
RNN_BLOCK = D_RNN // N_RNN_BLOCKS
CONV_W = 4
CONV_LEFT = CONV_W // 2
LRU_C = 8.0
N_XHEADS = 4
XHEAD_DIM = D_MODEL // N_XHEADS
D_FF = 4 * D_MODEL
N_IN = ATTN_W + 2 * KV_W + 2 * D_RNN + 2 * D_MODEL
SPLITS = [ATTN_W, ATTN_W + KV_W, ATTN_W + 2 * KV_W, ATTN_W + 2 * KV_W + D_RNN,
          ATTN_W + 2 * KV_W + 2 * D_RNN, ATTN_W + 2 * KV_W + 2 * D_RNN + D_MODEL]
EPS = 1e-6

kernel_name = 'hybrid_gqa_rglru_xattn_encoder'


def rmsnorm(x, g):
    xf = x.astype(jnp.float32)
    y = xf * lax.rsqrt(jnp.mean(xf * xf, axis=-1, keepdims=True) + EPS)
    return (y * g.astype(jnp.float32)).astype(x.dtype)


def axial_rope_tables(seq_len):
    rows_n = seq_len // GRID_W
    row = jnp.repeat(jnp.arange(rows_n, dtype=jnp.float32), GRID_W)
    col = jnp.tile(jnp.arange(GRID_W, dtype=jnp.float32), rows_n)
    n_freq = ROPE_HALF // 2
    inv = ROPE_THETA ** (-jnp.arange(n_freq, dtype=jnp.float32) / n_freq)
    ang_r = row[:, None] * inv[None, :]
    ang_c = col[:, None] * inv[None, :]
    return (jnp.cos(ang_r), jnp.sin(ang_r), jnp.cos(ang_c), jnp.sin(ang_c))


def _rotate(x, cos, sin):
    n = x.shape[-1] // 2
    x1, x2 = x[..., :n], x[..., n:]
    c = cos[None, :, None, :]
    s = sin[None, :, None, :]
    return jnp.concatenate([x1 * c - x2 * s, x2 * c + x1 * s], axis=-1)


def head_norm_axial_rope(x, g, tabs):
    cr, sr, cc, sc = tabs
    xf = x.astype(jnp.float32)
    xf = xf * lax.rsqrt(jnp.mean(xf * xf, axis=-1, keepdims=True) + EPS) * g.astype(jnp.float32)
    out = jnp.concatenate([_rotate(xf[..., :ROPE_HALF], cr, sr),
                           _rotate(xf[..., ROPE_HALF:], cc, sc)], axis=-1)
    return out.astype(x.dtype)


def block_gqa(q, k, v):
    B, S = q.shape[0], q.shape[1]
    nb = S // Q_BLOCK
    qb = q.reshape(B, nb, Q_BLOCK, N_KV_HEADS, GROUP, HEAD_DIM).transpose(1, 0, 2, 3, 4, 5)
    scale = HEAD_DIM ** -0.5

    def one_block(qblk):
        s = jnp.einsum('bqkgd,bskd->bkgqs', qblk, k, preferred_element_type=jnp.float32) * scale
        p = jax.nn.softmax(s, axis=-1).astype(v.dtype)
        return jnp.einsum('bkgqs,bskd->bqkgd', p, v)

    o = lax.map(one_block, qb)
    return o.transpose(1, 0, 2, 3, 4, 5).reshape(B, S, ATTN_W)


def centred_depthwise_conv(u, w, b):
    S = u.shape[1]
    up = jnp.pad(u, ((0, 0), (CONV_LEFT, CONV_W - 1 - CONV_LEFT), (0, 0)))
    out = b[None, None, :]
    for tap in range(CONV_W):
        out = out + up[:, tap:tap + S, :] * w[tap][None, None, :]
    return out


def _lru_combine(e1, e2):
    a1, b1 = e1
    a2, b2 = e2
    return a1 * a2, a2 * b1 + b2


def rglru_direction(u, w_r, b_r, w_i, b_i, lam, reverse):
    B, S, _ = u.shape
    ub = u.reshape(B, S, N_RNN_BLOCKS, RNN_BLOCK)
    r = jax.nn.sigmoid(jnp.einsum('bsnc,ncd->bsnd', ub, w_r.astype(jnp.float32)).reshape(B, S, D_RNN)
                       + b_r.astype(jnp.float32))
    i = jax.nn.sigmoid(jnp.einsum('bsnc,ncd->bsnd', ub, w_i.astype(jnp.float32)).reshape(B, S, D_RNN)
                       + b_i.astype(jnp.float32))
    log_a = -LRU_C * r * jax.nn.softplus(-lam.astype(jnp.float32))
    a = jnp.exp(log_a)
    bterm = jnp.sqrt(-jnp.expm1(2.0 * log_a)) * (i * u)
    if reverse:
        a = jnp.flip(a, axis=1)
        bterm = jnp.flip(bterm, axis=1)
    _, h = lax.associative_scan(_lru_combine, (a, bterm), axis=1)
    if reverse:
        h = jnp.flip(h, axis=1)
    return h


def setup_inputs(seed: int = 0) -> dict:
    key = jax.random.key(seed)
    ks = jax.random.split(key, 32)
    f32 = jnp.float32

    def nrm(k, shape, fan_in):
        return jax.random.normal(k, shape, f32) * (fan_in ** -0.5)

    def gain(k, shape):
        return 1.0 + 0.02 * jax.random.normal(k, shape, f32)

    u = jax.random.uniform(ks[12], (DEPTH, 2, D_RNN), f32, 0.9, 0.999)
    a0 = u ** (1.0 / LRU_C)
    lam = jnp.log(a0) - jnp.log1p(-a0)
    return {
        'x': jax.random.normal(ks[0], (BATCH, SEQ, D_MODEL), f32),
        'mem': jax.random.normal(ks[1], (BATCH, N_MEM, D_MODEL), f32),
        'mix_norm_g': gain(ks[2], (DEPTH, D_MODEL)),
        'w_in': nrm(ks[3], (DEPTH, D_MODEL, N_IN), D_MODEL),
        'q_norm_g': gain(ks[4], (DEPTH, HEAD_DIM)),
        'k_norm_g': gain(ks[5], (DEPTH, HEAD_DIM)),
        'conv_w': nrm(ks[6], (DEPTH, CONV_W, D_RNN), CONV_W),
        'conv_b': 0.01 * jax.random.normal(ks[7], (DEPTH, D_RNN), f32),
        'lru_w_r': nrm(ks[8], (DEPTH, 2, N_RNN_BLOCKS, RNN_BLOCK, RNN_BLOCK), RNN_BLOCK),
        'lru_b_r': 0.01 * jax.random.normal(ks[9], (DEPTH, 2, D_RNN), f32),
        'lru_w_i': nrm(ks[10], (DEPTH, 2, N_RNN_BLOCKS, RNN_BLOCK, RNN_BLOCK), RNN_BLOCK),
        'lru_b_i': 0.01 * jax.random.normal(ks[11], (DEPTH, 2, D_RNN), f32),
        'lru_lambda': lam,
        'w_attn_branch': nrm(ks[13], (DEPTH, ATTN_W, D_MODEL), ATTN_W),
        'w_rnn_branch': nrm(ks[14], (DEPTH, D_RNN, D_MODEL), D_RNN),
        'w_mix_out': nrm(ks[15], (DEPTH, D_MODEL, D_MODEL), D_MODEL),
        'cross_norm_g': gain(ks[16], (DEPTH, D_MODEL)),
        'mem_norm_g': gain(ks[17], (DEPTH, D_MODEL)),
        'w_xq': nrm(ks[18], (DEPTH, D_MODEL, D_MODEL), D_MODEL),
        'w_xkv': nrm(ks[19], (DEPTH, D_MODEL, 2 * D_MODEL), D_MODEL),
        'w_xo': nrm(ks[20], (DEPTH, D_MODEL, D_MODEL), D_MODEL),
        'mlp_norm_g': gain(ks[21], (DEPTH, D_MODEL)),
        'w_up': nrm(ks[22], (DEPTH, D_MODEL, D_FF), D_MODEL),
        'w_down': nrm(ks[23], (DEPTH, D_FF, D_MODEL), D_FF),
        'final_norm_g': gain(ks[24], (D_MODEL,)),
    }


def reference(x, mem, mix_norm_g, w_in, q_norm_g, k_norm_g, conv_w, conv_b, lru_w_r, lru_b_r,
              lru_w_i, lru_b_i, lru_lambda, w_attn_branch, w_rnn_branch, w_mix_out, cross_norm_g,
              mem_norm_g, w_xq, w_xkv, w_xo, mlp_norm_g, w_up, w_down, final_norm_g):
    B, S, _ = x.shape
    M = mem.shape[1]
    dt = x.dtype
    tabs = axial_rope_tables(S)
    for l in range(DEPTH):
        h = rmsnorm(x, mix_norm_g[l])
        proj = h @ w_in[l]
        q, k, v, u, y, g_a, g_r = jnp.split(proj, SPLITS, axis=-1)
        q = head_norm_axial_rope(q.reshape(B, S, N_Q_HEADS, HEAD_DIM), q_norm_g[l], tabs)
        k = head_norm_axial_rope(k.reshape(B, S, N_KV_HEADS, HEAD_DIM), k_norm_g[l], tabs)
        v = v.reshape(B, S, N_KV_HEADS, HEAD_DIM)
        o_attn = block_gqa(q, k, v)
        uf = centred_depthwise_conv(u.astype(jnp.float32), conv_w[l].astype(jnp.float32),
                                    conv_b[l].astype(jnp.float32))
        h_fwd = rglru_direction(uf, lru_w_r[l, 0], lru_b_r[l, 0], lru_w_i[l, 0], lru_b_i[l, 0],
                                lru_lambda[l, 0], reverse=False)
        h_bwd = rglru_direction(uf, lru_w_r[l, 1], lru_b_r[l, 1], lru_w_i[l, 1], lru_b_i[l, 1],
                                lru_lambda[l, 1], reverse=True)
        o_rnn = ((h_fwd + h_bwd) * jax.nn.gelu(y.astype(jnp.float32))).astype(dt)
        merged = (jax.nn.sigmoid(g_a) * (o_attn @ w_attn_branch[l])
                  + jax.nn.sigmoid(g_r) * (o_rnn @ w_rnn_branch[l]))
        x = x + merged @ w_mix_out[l]
        hc = rmsnorm(x, cross_norm_g[l])
        mn = rmsnorm(mem, mem_norm_g[l])
        xq = (hc @ w_xq[l]).reshape(B, S, N_XHEADS, XHEAD_DIM)
        xk, xv = jnp.split(mn @ w_xkv[l], 2, axis=-1)
        xk = xk.reshape(B, M, N_XHEADS, XHEAD_DIM)
        xv = xv.reshape(B, M, N_XHEADS, XHEAD_DIM)
        s = jnp.einsum('bshd,bmhd->bhsm', xq, xk, preferred_element_type=jnp.float32) * (XHEAD_DIM ** -0.5)
        p = jax.nn.softmax(s, axis=-1).astype(dt)
        xo = jnp.einsum('bhsm,bmhd->bshd', p, xv).reshape(B, S, D_MODEL)
        x = x + xo @ w_xo[l]
        hm = rmsnorm(x, mlp_norm_g[l])
        x = x + jnp.square(jax.nn.relu(hm @ w_up[l])) @ w_down[l]
    return rmsnorm(x, final_norm_g)
```

```cpp
#include <hip/hip_runtime.h>
#include <hip/hip_cooperative_groups.h>
#include <cstdio>
#include <cstdint>
namespace cg = cooperative_groups;

#ifndef MK_ONE_LAUNCH
#define MK_ONE_LAUNCH 1
#endif

#ifndef PH_MASK
#define PH_MASK 0xfffff
#endif
#define PHM(i) ((PH_MASK >> (i)) & 1)
#ifndef PROBE_Q
#define PROBE_Q -1
#endif
#ifndef PROBE_N
#define PROBE_N 1
#endif
#ifndef PROBE_SUB
#define PROBE_SUB 3
#endif
#ifndef PROBE_ABL
#define PROBE_ABL 0
#endif
#ifndef PROBE_SYNC
#define PROBE_SYNC 0
#endif
constexpr size_t WS_DUMMY = (size_t)604 << 20;
#define LAS __attribute__((address_space(3)))
typedef unsigned short bf16_t;
typedef short bf16x8 __attribute__((ext_vector_type(8)));
typedef short s16x4 __attribute__((ext_vector_type(4)));
typedef float f32x4 __attribute__((ext_vector_type(4)));
typedef float f32x2 __attribute__((ext_vector_type(2)));
typedef float f32x16 __attribute__((ext_vector_type(16)));
typedef unsigned u32x4 __attribute__((ext_vector_type(4)));
typedef unsigned u32x2 __attribute__((ext_vector_type(2)));

constexpr int DM = 2048, NB = 4, SEQ = 4096, MT = NB * SEQ, NIN = 11264, FF = 8192, NMEM = 256, MMEM = NB * NMEM;
constexpr float EPS = 1e-6f;
constexpr int NPH_LAYER = 12, NPH = 2 * NPH_LAYER + 1;

constexpr size_t MiB = 1u << 20;
constexpr size_t WS_ROWSS = 0;
constexpr size_t CTL_BYTES = 2 * MiB;
constexpr size_t WS_BAR = 1536 * 1024;
constexpr size_t WS_ROPE = 2 * MiB;
constexpr size_t WS_MN = 10 * MiB;
constexpr size_t WS_MEMK = 14 * MiB;
constexpr size_t WS_MEMVT = 18 * MiB;
constexpr size_t WS_W = 22 * MiB;
constexpr size_t W_IN = 0, W_A = 44 * MiB, W_R = 52 * MiB, W_MIX = 60 * MiB, W_XQ = 68 * MiB, W_XO = 76 * MiB, W_XKV = 84 * MiB,
                 W_UP = 100 * MiB, W_DOWN = 132 * MiB, W_LRU = 164 * MiB, W_END = 166 * MiB;
constexpr size_t WS_XB = WS_W + W_END;
constexpr size_t WS_Q = 252 * MiB, WS_K = 316 * MiB, WS_V = 332 * MiB, WS_U = 348 * MiB, WS_Y = 412 * MiB, WS_GA = 476 * MiB, WS_GR = 540 * MiB;
constexpr size_t WS_MERGED = WS_K;
constexpr size_t WS_XQ = WS_Q, WS_P = 380 * MiB, WS_XO = WS_Y, WS_H = WS_Q;
constexpr size_t WS_HF = 604 * MiB;
constexpr size_t WS_UF = 732 * MiB;
constexpr size_t WS_END = 796 * MiB;

constexpr int LDS_BYTES = 147456;

__device__ __forceinline__ unsigned cvt_pk_bf16(float lo, float hi) { unsigned r; asm volatile("v_cvt_pk_bf16_f32 %0, %1, %2" : "=v"(r) : "v"(lo), "v"(hi)); return r; }
__device__ __forceinline__ float bf_lo(unsigned u) { return __uint_as_float(u << 16); }
__device__ __forceinline__ float bf_hi(unsigned u) { return __uint_as_float(u & 0xffff0000u); }
__device__ __forceinline__ float bf1(bf16_t h) { return __uint_as_float(((unsigned)h) << 16); }
__device__ __forceinline__ float fast_sigmoid(float x) { return __builtin_amdgcn_rcpf(1.0f + __expf(-x)); }
#define CUR_LANE() ({ int l__; asm volatile("v_mbcnt_lo_u32_b32 %0, -1, 0\n\tv_mbcnt_hi_u32_b32 %0, -1, %0" : "=v"(l__)); l__; })
__device__ __forceinline__ float shx(float v, int m) { const int l = CUR_LANE(); return __int_as_float(__builtin_amdgcn_ds_bpermute((l ^ m) << 2, __float_as_int(v))); }
__device__ __forceinline__ float wave_sum(float v) {
    const int l = CUR_LANE();
#pragma unroll
    for (int o = 1; o < 64; o <<= 1) v += __int_as_float(__builtin_amdgcn_ds_bpermute((l ^ o) << 2, __float_as_int(v)));
    return v;
}
__device__ __forceinline__ float softplus_neg(float lam) {
    const float e = __expf(-lam);
    const float ser = e * (1.0f - e * (0.5f - e * (0.33333334f - e * (0.25f - e * 0.2f))));
    return (lam > 2.3f) ? ser : ((lam > -15.f) ? __logf(1.0f + e) : -lam);
}
__device__ __forceinline__ void store8_bf16(bf16_t* p, f32x4 v0, f32x4 v1) {
    u32x4 w; w.x = cvt_pk_bf16(v0[0], v0[1]); w.y = cvt_pk_bf16(v0[2], v0[3]); w.z = cvt_pk_bf16(v1[0], v1[1]); w.w = cvt_pk_bf16(v1[2], v1[3]);
    *(u32x4*)p = w;
}
#define LDS_WAIT() asm volatile("s_waitcnt lgkmcnt(0)" ::: "memory")
typedef unsigned long long u64;
__device__ __forceinline__ float ss_to_f(u64 v) { return (float)v * (1.0f / 16777216.0f); }
__device__ __forceinline__ u64 f_to_ss(float s) { return (u64)(s * 16777216.0f); }

namespace pg8 {
constexpr int BM = 256, BK = 64, HALF = 128, HTB = HALF * BK * 2, STAGE_BYTES = 8 * HTB, NXCD = 8, WGM = 2;
__host__ __device__ __forceinline__ int lds_byte(int r, int c) { const int st = (r >> 4) * 2 + (c >> 5), rr = r & 15, cc = c & 31, ob = rr * 64 + cc * 2; return st * 1024 + (ob ^ (((ob >> 9) & 1) << 5)); }
__host__ __device__ __forceinline__ void stage_rc(int b, int& R, int& C) { const int st = b / 1024, sb = b % 1024, swz = sb ^ (((sb >> 9) & 1) << 5); R = (st >> 1) * 16 + swz / 64; C = (st & 1) * 32 + (swz % 64) / 2; }
__host__ __device__ __forceinline__ int perm32(int rho) { const int n = rho >> 4, i = rho & 15; return 8 * (i >> 2) + 4 * n + (i & 3); }

struct Unit { int pm, pn, sub; const char* a; const char* b; };

struct TileOrder {
    int nM, nN, nwg, G, c;
    __device__ __forceinline__ void init(int M, int N, int G_, int c_) { nM = M / BM; nN = N / BM; nwg = nM * nN; G = G_; c = c_; }
    __device__ __forceinline__ bool tile(int i, int& pm, int& pn) const {
        const long L = (long)i * G + c; if (L >= nwg) return false;
        int wgid = (int)L; { const int q = nwg / NXCD, r = nwg % NXCD, xcd = wgid % NXCD, off = wgid / NXCD; wgid = (xcd < r ? xcd * (q + 1) : r * (q + 1) + (xcd - r) * q) + off; }
        const int nig = WGM * nN, gid = wgid / nig, fm = gid * WGM, gsz = (nM - fm) < WGM ? (nM - fm) : WGM;
        pm = fm + ((wgid % nig) % gsz); pn = (wgid % nig) / gsz; return true;
    }
};
struct SchedPlain {
    TileOrder o; const char* A; const char* B; size_t tA, tB;
    __device__ __forceinline__ bool next(int i, Unit& u) const { if (!o.tile(i, u.pm, u.pn)) return false; u.sub = 0; u.a = A + (size_t)u.pm * tA; u.b = B + (size_t)u.pn * tB; return true; }
};
struct SchedDual {
    TileOrder o; const char* A; const char* B; const char* A2; const char* B2; size_t tA, tB;
    __device__ __forceinline__ bool next(int i, Unit& u) const { if (!o.tile(i >> 1, u.pm, u.pn)) return false; u.sub = i & 1;
        u.a = ((i & 1) ? A2 : A) + (size_t)u.pm * tA; u.b = ((i & 1) ? B2 : B) + (size_t)u.pn * tB; return true; }
};
struct SchedOne { Unit u; __device__ __forceinline__ bool next(int i, Unit& o) const { if (i) return false; o = u; return true; } };

#define PG8_ACC f32x4 (&acc)[2][2][4][2]
struct EpiPlain {
    static constexpr bool AFTER_DRAIN = false, ACCUM2 = false;
    bf16_t* O; int ldc;
    __device__ __forceinline__ void operator()(PG8_ACC, const Unit& u, int wr, int wc, int fr, int fq) const {
        bf16_t* base = O + (size_t)(u.pm * BM + wr * 64 + fr) * ldc + u.pn * BM + wc * 32 + 8 * fq;
#pragma unroll
        for (int ai = 0; ai < 2; ++ai)
#pragma unroll
            for (int m = 0; m < 4; ++m)
#pragma unroll
                for (int bj = 0; bj < 2; ++bj) store8_bf16(base + (size_t)(ai * HALF + m * 16) * ldc + bj * HALF, acc[ai][bj][m][0], acc[ai][bj][m][1]);
    }
};
struct EpiRow1 {
    static constexpr bool AFTER_DRAIN = false, ACCUM2 = false;
    bf16_t* O; int ldc; const u64* rowss; int act;
    __device__ __forceinline__ void operator()(PG8_ACC, const Unit& u, int wr, int wc, int fr, int fq) const {
        const int row0 = u.pm * BM + wr * 64 + fr;
        bf16_t* base = O + (size_t)row0 * ldc + u.pn * BM + wc * 32 + 8 * fq;
        float rs[2][4];
#pragma unroll
        for (int ai = 0; ai < 2; ++ai)
#pragma unroll
            for (int m = 0; m < 4; ++m) rs[ai][m] = ss_to_f(rowss[row0 + ai * HALF + m * 16]);
#pragma unroll
        for (int ai = 0; ai < 2; ++ai)
#pragma unroll
            for (int m = 0; m < 4; ++m) { const float r = __builtin_amdgcn_rsqf(rs[ai][m] * (1.0f / DM) + EPS);
#pragma unroll
                for (int bj = 0; bj < 2; ++bj) { f32x4 v0 = acc[ai][bj][m][0] * r, v1 = acc[ai][bj][m][1] * r;
                    if (act) { v0 = __builtin_elementwise_max(v0, (f32x4){0.f, 0.f, 0.f, 0.f}); v1 = __builtin_elementwise_max(v1, (f32x4){0.f, 0.f, 0.f, 0.f}); v0 = v0 * v0; v1 = v1 * v1; }
                    store8_bf16(base + (size_t)(ai * HALF + m * 16) * ldc + bj * HALF, v0, v1); } }
    }
};
struct EpiG1 {
    static constexpr bool AFTER_DRAIN = false, ACCUM2 = false;
    unsigned char* ws; const u64* rowss;
    __device__ __forceinline__ void operator()(PG8_ACC, const Unit& u, int wr, int wc, int fr, int fq) const {
        const int pn = u.pn; size_t off; int ldc, ct;
        if (pn < 8) { off = WS_Q; ldc = 2048; ct = pn; } else if (pn < 10) { off = WS_K; ldc = 512; ct = pn - 8; } else if (pn < 12) { off = WS_V; ldc = 512; ct = pn - 10; }
        else if (pn < 20) { off = WS_U; ldc = 2048; ct = pn - 12; } else if (pn < 28) { off = WS_Y; ldc = 2048; ct = pn - 20; } else if (pn < 36) { off = WS_GA; ldc = 2048; ct = pn - 28; }
        else { off = WS_GR; ldc = 2048; ct = pn - 36; }
        const int row0 = u.pm * BM + wr * 64 + fr;
        bf16_t* base = (bf16_t*)(ws + off) + (size_t)row0 * ldc + ct * BM + wc * 32 + 8 * fq;
        float rs[2][4];
#pragma unroll
        for (int ai = 0; ai < 2; ++ai)
#pragma unroll
            for (int m = 0; m < 4; ++m) rs[ai][m] = ss_to_f(rowss[row0 + ai * HALF + m * 16]);
#pragma unroll
        for (int ai = 0; ai < 2; ++ai)
#pragma unroll
            for (int m = 0; m < 4; ++m) { const float r = __builtin_amdgcn_rsqf(rs[ai][m] * (1.0f / DM) + EPS);
#pragma unroll
                for (int bj = 0; bj < 2; ++bj) store8_bf16(base + (size_t)(ai * HALF + m * 16) * ldc + bj * HALF, acc[ai][bj][m][0] * r, acc[ai][bj][m][1] * r); }
    }
};
struct EpiGate {
    static constexpr bool AFTER_DRAIN = false, ACCUM2 = true;
    const bf16_t* GA; const bf16_t* GR; bf16_t* O;
    __device__ __forceinline__ void operator()(PG8_ACC, const Unit& u, int wr, int wc, int fr, int fq) const {
        const size_t o0 = (size_t)(u.pm * BM + wr * 64 + fr) * DM + u.pn * BM + wc * 32 + 8 * fq;
        const bf16_t* __restrict__ ga_ = GA; const bf16_t* __restrict__ gr_ = GR; bf16_t* __restrict__ out_ = O;
#pragma unroll
        for (int ai = 0; ai < 2; ++ai) {
            u32x4 grv[4][2], gav[4][2];
#pragma unroll
            for (int m = 0; m < 4; ++m)
#pragma unroll
                for (int bj = 0; bj < 2; ++bj) { const size_t o = o0 + (size_t)(ai * HALF + m * 16) * DM + bj * HALF; grv[m][bj] = *(const u32x4*)(gr_ + o); if (u.sub == 0) gav[m][bj] = *(const u32x4*)(ga_ + o); }
#pragma unroll
            for (int m = 0; m < 4; ++m)
#pragma unroll
                for (int bj = 0; bj < 2; ++bj) { const size_t o = o0 + (size_t)(ai * HALF + m * 16) * DM + bj * HALF;
                    const u32x4 gr = grv[m][bj]; float er[8];
#pragma unroll
                    for (int e = 0; e < 4; ++e) { er[2 * e] = 1.0f + __expf(-bf_lo(gr[e])); er[2 * e + 1] = 1.0f + __expf(-bf_hi(gr[e])); }
                    if (u.sub == 0) { const u32x4 ga = gav[m][bj];
#pragma unroll
                        for (int e = 0; e < 4; ++e) { const float a0 = 1.0f + __expf(-bf_lo(ga[e])), a1 = 1.0f + __expf(-bf_hi(ga[e]));
                            const float r0 = er[2 * e] * __builtin_amdgcn_rcpf(a0), r1 = er[2 * e + 1] * __builtin_amdgcn_rcpf(a1);
                            acc[ai][bj][m][e >> 1][(2 * e) & 3] *= r0; acc[ai][bj][m][e >> 1][(2 * e + 1) & 3] *= r1; }
                    } else { f32x4 v0, v1;
#pragma unroll
                        for (int e = 0; e < 4; ++e) { v0[e] = acc[ai][bj][m][0][e] * __builtin_amdgcn_rcpf(er[e]); v1[e] = acc[ai][bj][m][1][e] * __builtin_amdgcn_rcpf(er[4 + e]); }
                        store8_bf16(out_ + o, v0, v1); } }
        }
    }
};
struct EpiRes {
    static constexpr bool AFTER_DRAIN = false, ACCUM2 = false;
    bf16_t* XB; float* out32; u64* rowss;
    __device__ __forceinline__ void operator()(PG8_ACC, const Unit& u, int wr, int wc, int fr, int fq) const {
        const int row0 = u.pm * BM + wr * 64 + fr;
        const size_t o0 = (size_t)row0 * DM + u.pn * BM + wc * 32 + 8 * fq;
#pragma unroll
        for (int ai = 0; ai < 2; ++ai) {
            u32x4 xv[4][2];
#pragma unroll
            for (int m = 0; m < 4; ++m)
#pragma unroll
                for (int bj = 0; bj < 2; ++bj) xv[m][bj] = *(const u32x4*)(XB + o0 + (size_t)(ai * HALF + m * 16) * DM + bj * HALF);
#pragma unroll
            for (int m = 0; m < 4; ++m) { float ss = 0.f;
#pragma unroll
                for (int bj = 0; bj < 2; ++bj) { const size_t o = o0 + (size_t)(ai * HALF + m * 16) * DM + bj * HALF; const u32x4 q = xv[m][bj];
                    const f32x4 v0 = (f32x4){bf_lo(q.x), bf_hi(q.x), bf_lo(q.y), bf_hi(q.y)} + acc[ai][bj][m][0], v1 = (f32x4){bf_lo(q.z), bf_hi(q.z), bf_lo(q.w), bf_hi(q.w)} + acc[ai][bj][m][1];
                    if (out32) { *(f32x4*)(out32 + o) = v0; *(f32x4*)(out32 + o + 4) = v1; } else store8_bf16(XB + o, v0, v1);
                    ss += (v0[0] * v0[0] + v0[1] * v0[1]) + (v0[2] * v0[2] + v0[3] * v0[3]) + (v1[0] * v1[0] + v1[1] * v1[1]) + (v1[2] * v1[2] + v1[3] * v1[3]); }
                ss += shx(ss, 16); ss += shx(ss, 32);
                if (fq == 0) atomicAdd(rowss + row0 + ai * HALF + m * 16, f_to_ss(ss)); }
        }
    }
};
struct EpiSoftmax {
    static constexpr bool AFTER_DRAIN = true, ACCUM2 = false;
    bf16_t* O; int ldc;
    __device__ __forceinline__ void operator()(PG8_ACC, const Unit&, int, int, int, int) const {}
    __device__ __forceinline__ void fused(PG8_ACC, const Unit& u, int wr, int wc, int fr, int fq, LAS unsigned char* lds) const {
        LAS float* PM = (LAS float*)lds; LAS float* PS = (LAS float*)(lds + 4096);
#pragma unroll
        for (int ai = 0; ai < 2; ++ai)
#pragma unroll
            for (int m = 0; m < 4; ++m) { float mx = -3.0e38f;
#pragma unroll
                for (int bj = 0; bj < 2; ++bj)
#pragma unroll
                    for (int n = 0; n < 2; ++n) { const f32x4 x = acc[ai][bj][m][n]; mx = fmaxf(mx, fmaxf(fmaxf(x[0], x[1]), fmaxf(x[2], x[3]))); }
                mx = fmaxf(mx, shx(mx, 16)); mx = fmaxf(mx, shx(mx, 32));
                if (fq == 0) PM[(ai * HALF + wr * 64 + m * 16 + fr) * 4 + wc] = mx; }
        LDS_WAIT(); __builtin_amdgcn_s_barrier(); asm volatile("" ::: "memory");
#pragma unroll
        for (int ai = 0; ai < 2; ++ai)
#pragma unroll
            for (int m = 0; m < 4; ++m) { const int r = ai * HALF + wr * 64 + m * 16 + fr; const f32x4 q = *(const LAS f32x4*)(PM + r * 4);
                const float mm = fmaxf(fmaxf(q[0], q[1]), fmaxf(q[2], q[3])) * 1.4426950408889634f; float s = 0.f;
#pragma unroll
                for (int bj = 0; bj < 2; ++bj)
#pragma unroll
                    for (int n = 0; n < 2; ++n)
#pragma unroll
                        for (int e = 0; e < 4; ++e) { const float p = __builtin_amdgcn_exp2f(acc[ai][bj][m][n][e] * 1.4426950408889634f - mm); acc[ai][bj][m][n][e] = p; s += p; }
                s += shx(s, 16); s += shx(s, 32);
                if (fq == 0) PS[r * 4 + wc] = s; }
        LDS_WAIT(); __builtin_amdgcn_s_barrier(); asm volatile("" ::: "memory");
        bf16_t* base = O + (size_t)(u.pm * BM + wr * 64 + fr) * ldc + u.pn * BM + wc * 32 + 8 * fq;
#pragma unroll
        for (int ai = 0; ai < 2; ++ai)
#pragma unroll
            for (int m = 0; m < 4; ++m) { const int r = ai * HALF + wr * 64 + m * 16 + fr; const f32x4 q = *(const LAS f32x4*)(PS + r * 4);
                const float inv = __builtin_amdgcn_rcpf((q[0] + q[1]) + (q[2] + q[3]));
#pragma unroll
                for (int bj = 0; bj < 2; ++bj) store8_bf16(base + (size_t)(ai * HALF + m * 16) * ldc + bj * HALF, acc[ai][bj][m][0] * inv, acc[ai][bj][m][1] * inv); }
        LDS_WAIT(); __builtin_amdgcn_s_barrier(); asm volatile("" ::: "memory");
    }
};

template <class Epi, class Sched, bool ALIGN_EPI>
__device__ __forceinline__ void gemm_phase(LAS unsigned char* lds, const int tid, const int K, const int lda, const int ldb, const Sched& S, const Epi& E) {
    const int wid = __builtin_amdgcn_readfirstlane(tid >> 6), lane = tid & 63, wr = wid >> 2, wc = wid & 3, fr = lane & 15, fq = lane >> 4;
    const int nt = K / BK;
    unsigned voffA[2], voffB[2];
#pragma unroll
    for (int i = 0; i < 2; ++i) { int R, C; stage_rc(tid * 16 + i * 8192, R, C); const int Rb = (R & ~31) + perm32(R & 31);
        voffA[i] = (unsigned)(R * lda + C) * 2u; voffB[i] = (unsigned)(Rb * ldb + C) * 2u; }
    const size_t kstep = (size_t)(BK * 2);
    const size_t hstepA = (size_t)HALF * lda * 2, hstepB = (size_t)HALF * ldb * 2;
    const unsigned ldsw = (unsigned)wid * 1024u;
    const int aoff = lds_byte(wr * 64 + fr, fq * 8), boff = lds_byte(wc * 32 + fr, fq * 8);
#define PG8_SA(b, h) (((b) * 2 + (h)) * HTB)
#define PG8_SB(b, h) ((4 + (b) * 2 + (h)) * HTB)
#define PG8_STAGE(bufoff, gbase, voff) do { _Pragma("unroll") for (int _i = 0; _i < 2; ++_i) \
        __builtin_amdgcn_global_load_lds((const unsigned*)((const char*)(gbase) + (voff)[_i]), (LAS unsigned*)(lds + (bufoff) + ldsw + _i * 8192), 16, 0, 0); } while (0)
#define PG8_LDA(dst, b, h) do { _Pragma("unroll") for (int m = 0; m < 4; ++m) _Pragma("unroll") for (int k = 0; k < 2; ++k) dst[m][k] = *(const LAS bf16x8*)(lds + PG8_SA(b, h) + aoff + m * 2048 + k * 1024); } while (0)
#define PG8_LDB(dst, b, h) do { _Pragma("unroll") for (int n = 0; n < 2; ++n) _Pragma("unroll") for (int k = 0; k < 2; ++k) dst[n][k] = *(const LAS bf16x8*)(lds + PG8_SB(b, h) + boff + n * 2048 + k * 1024); } while (0)
#define PG8_MMA(ai, bj, At, Bt) do { __builtin_amdgcn_s_setprio(1); _Pragma("unroll") for (int m = 0; m < 4; ++m) _Pragma("unroll") for (int n = 0; n < 2; ++n) _Pragma("unroll") for (int k = 0; k < 2; ++k) \
        acc[ai][bj][m][n] = __builtin_amdgcn_mfma_f32_16x16x32_bf16(Bt[n][k], At[m][k], acc[ai][bj][m][n], 0, 0, 0); __builtin_amdgcn_s_setprio(0); } while (0)
#define PG8_WAIT_V(n) asm volatile("s_waitcnt vmcnt(" #n ")" ::: "memory")
#define PG8_WAIT_L(n) asm volatile("s_waitcnt lgkmcnt(" #n ")" ::: "memory")
#define PG8_BAR __builtin_amdgcn_s_barrier()
#define PG8_SCHED __builtin_amdgcn_sched_barrier(0)
#define PG8_ZERO() do { _Pragma("unroll") for (int a = 0; a < 2; ++a) _Pragma("unroll") for (int b = 0; b < 2; ++b) _Pragma("unroll") for (int m = 0; m < 4; ++m) _Pragma("unroll") for (int n = 0; n < 2; ++n) acc[a][b][m][n] = (f32x4){0.f, 0.f, 0.f, 0.f}; } while (0)
    Unit cur, nxt; int ui = 0;
    if (!S.next(0, cur)) return;
    f32x4 acc[2][2][4][2];
    PG8_ZERO();
    bf16x8 At[4][2], B0[2][2], B1[2][2];
    const char* cA = cur.a; const char* cB = cur.b;
    PG8_STAGE(PG8_SB(0, 0), cB, voffB); PG8_STAGE(PG8_SB(0, 1), cB + hstepB, voffB); PG8_STAGE(PG8_SA(0, 0), cA, voffA); PG8_STAGE(PG8_SA(0, 1), cA + hstepA, voffA);
    if (wr == 1) PG8_BAR;
    PG8_WAIT_V(2); PG8_BAR;
    PG8_STAGE(PG8_SB(1, 0), cB + kstep, voffB); PG8_STAGE(PG8_SA(1, 0), cA + kstep, voffA); PG8_STAGE(PG8_SB(1, 1), cB + hstepB + kstep, voffB);
    PG8_WAIT_V(6); PG8_BAR;
    for (;;) {
        const bool has_next = S.next(ui + 1, nxt);
        const char* nA = has_next ? nxt.a : cA; const char* nB = has_next ? nxt.b : cB;
#pragma nounroll
        for (int t = 0; t < nt; t += 2) {
            const bool last = (t == nt - 2);
            const char* a1 = cA + (size_t)(t + 1) * kstep;
            const char* a2 = last ? nA : cA + (size_t)(t + 2) * kstep; const char* b2 = last ? nB : cB + (size_t)(t + 2) * kstep;
            const char* a3 = a2 + kstep; const char* b3 = b2 + kstep;
            PG8_LDB(B0, 0, 0); PG8_LDB(B1, 0, 1); PG8_SCHED; PG8_LDA(At, 0, 0); PG8_STAGE(PG8_SA(1, 1), a1 + hstepA, voffA);
            PG8_WAIT_V(8); PG8_WAIT_L(0); PG8_BAR; PG8_MMA(0, 0, At, B0); PG8_MMA(0, 1, At, B1); PG8_BAR; PG8_SCHED;
            PG8_LDA(At, 0, 1); PG8_STAGE(PG8_SB(0, 0), b2, voffB); PG8_STAGE(PG8_SB(0, 1), b2 + hstepB, voffB); PG8_STAGE(PG8_SA(0, 0), a2, voffA);
            PG8_WAIT_V(8); PG8_WAIT_L(0); PG8_BAR; PG8_MMA(1, 0, At, B0); PG8_MMA(1, 1, At, B1); PG8_BAR; PG8_SCHED;
            PG8_LDB(B0, 1, 0); PG8_LDB(B1, 1, 1); PG8_SCHED; PG8_LDA(At, 1, 0); PG8_STAGE(PG8_SA(0, 1), a2 + hstepA, voffA);
            PG8_WAIT_V(8); PG8_WAIT_L(0); PG8_BAR; PG8_MMA(0, 0, At, B0); PG8_MMA(0, 1, At, B1); PG8_BAR; PG8_SCHED;
            PG8_LDA(At, 1, 1); PG8_STAGE(PG8_SB(1, 0), b3, voffB); PG8_STAGE(PG8_SB(1, 1), b3 + hstepB, voffB); PG8_STAGE(PG8_SA(1, 0), a3, voffA);
            PG8_WAIT_V(8); PG8_WAIT_L(0); PG8_BAR; PG8_MMA(1, 0, At, B0); PG8_MMA(1, 1, At, B1); PG8_BAR; PG8_SCHED;
        }
        if constexpr (ALIGN_EPI) { if (wr == 0) PG8_BAR; }
        if constexpr (!Epi::AFTER_DRAIN) { E(acc, cur, wr, wc, fr, fq); }
        if (!has_next) break;
        if (!(Epi::ACCUM2 && cur.sub == 0)) PG8_ZERO();
        cur = nxt; cA = nA; cB = nB; ++ui;
        if constexpr (ALIGN_EPI) { if (wr == 1) PG8_BAR; }
    }
    PG8_WAIT_V(0);
    if constexpr (!ALIGN_EPI) { if (wr == 0) PG8_BAR; }
    PG8_BAR;
    if constexpr (Epi::AFTER_DRAIN) { E.fused(acc, cur, wr, wc, fr, fq, lds); }
#undef PG8_SA
#undef PG8_SB
#undef PG8_STAGE
#undef PG8_LDA
#undef PG8_LDB
#undef PG8_MMA
#undef PG8_WAIT_V
#undef PG8_WAIT_L
#undef PG8_BAR
#undef PG8_SCHED
#undef PG8_ZERO
}
}

namespace att {
constexpr int D = 128, NW = 8, QBLK = 32, KVBLK = 64;
constexpr float SCALE = 0.088388347648318440f;
constexpr float THR = 8.f;
constexpr int LDQ = 2048, LDK = 512, LDO = 2048;
constexpr size_t SHM_V = KVBLK * D * 2, SHM_K = KVBLK * D * 2, SHM_ATTN = 2 * SHM_V + 2 * SHM_K + NW * 64 * 4;
#define KSWZ(row, colB) ((row) * 256 + ((colB) ^ (((row) & 7) << 4)))
#define SBAR() __builtin_amdgcn_sched_barrier(0)
__device__ __forceinline__ int crow(int r, int hi) { return (r & 3) + 8 * (r >> 2) + 4 * hi; }
__device__ __forceinline__ void partialSM(f32x16& p0, f32x16& p1, float& m_reg, float& mn, float& alpha) {
  constexpr float C = SCALE * 1.4426950408889634f;
  float pmax = p0[0]; for (int r = 1; r < 16; ++r) pmax = fmaxf(pmax, p0[r]); for (int r = 0; r < 16; ++r) pmax = fmaxf(pmax, p1[r]);
  { auto rr = __builtin_amdgcn_permlane32_swap(__float_as_uint(pmax), __float_as_uint(pmax), false, false);
    pmax = fmaxf(__uint_as_float(rr[0]), __uint_as_float(rr[1])); }
  if (__builtin_expect(__all(pmax - m_reg <= THR / SCALE), 1)) { mn = m_reg; alpha = 1.f; }
  else { mn = fmaxf(m_reg, pmax); alpha = __builtin_amdgcn_exp2f((m_reg - mn) * C); m_reg = mn; }
  float mnC = -mn * C;
  for (int r = 0; r < 16; ++r) p0[r] = fmaf(p0[r], C, mnC); for (int r = 0; r < 16; ++r) p1[r] = fmaf(p1[r], C, mnC);
  for (int r = 0; r < 16; ++r) p0[r] = __builtin_amdgcn_exp2f(p0[r]);
}
__device__ __forceinline__ void finishSM(f32x16& p0, f32x16& p1, float alpha, float& l_reg, bf16x8& pa0, bf16x8& pa1, bf16x8& pa2, bf16x8& pa3) {
  for (int r = 0; r < 16; ++r) p1[r] = __builtin_amdgcn_exp2f(p1[r]);
  float ps = 0; for (int r = 0; r < 16; ++r) ps += p0[r]; for (int r = 0; r < 16; ++r) ps += p1[r];
  { auto rr = __builtin_amdgcn_permlane32_swap(__float_as_uint(ps), __float_as_uint(ps), false, false);
    ps = __uint_as_float(rr[0]) + __uint_as_float(rr[1]); }
  l_reg = l_reg * alpha + ps;
#define PK4(P, BASE, OUT) do { unsigned a0 = cvt_pk_bf16(P[BASE + 0], P[BASE + 1]), a1 = cvt_pk_bf16(P[BASE + 2], P[BASE + 3]);   \
    unsigned b0 = cvt_pk_bf16(P[BASE + 4], P[BASE + 5]), b1 = cvt_pk_bf16(P[BASE + 6], P[BASE + 7]);                              \
    auto r0 = __builtin_amdgcn_permlane32_swap(a0, b0, false, false); auto r1 = __builtin_amdgcn_permlane32_swap(a1, b1, false, false); \
    u32x4 w = {r0[0], r1[0], r0[1], r1[1]}; OUT = *reinterpret_cast<bf16x8*>(&w); } while (0)
  PK4(p0, 0, pa0); PK4(p0, 8, pa1); PK4(p1, 0, pa2); PK4(p1, 8, pa3);
#undef PK4
}
__device__ __forceinline__ void qkt(f32x16& p0, f32x16& p1, const bf16_t* Ks, const bf16x8* qr, int r32, int hi) {
  p0 = f32x16{}; p1 = f32x16{};
  for (int d0 = 0; d0 < 8; ++d0) { int cb = (d0 * 16 + hi * 8) * 2;
    bf16x8 b0 = *reinterpret_cast<const bf16x8*>((const char*)Ks + KSWZ(r32, cb));
    bf16x8 b1 = *reinterpret_cast<const bf16x8*>((const char*)Ks + KSWZ(32 + r32, cb));
    p0 = __builtin_amdgcn_mfma_f32_32x32x16_bf16(b0, qr[d0], p0, 0, 0, 0);
    p1 = __builtin_amdgcn_mfma_f32_32x32x16_bf16(b1, qr[d0], p1, 0, 0, 0); }
}
__device__ __forceinline__ int v_st(int k, int c) { const int kk = (k & ~0xC) | ((k & 4) << 1) | ((k & 8) >> 1); return ((kk >> 3) * 4 + (c >> 5)) * 512 + ((kk & 7) * 32 + (c & 31)) * 2; }
__device__ __forceinline__ int v_rd_base(int lane) { return ((lane & 3) << 3) | (((lane >> 2) & 3) << 6) | (((lane >> 4) & 1) << 5) | (((lane >> 5) & 1) << 8); }
constexpr int v_rd_off(int d0, int ks, int half) { return d0 * 512 + ks * 4096 + half * 2048; }
template <int OFF> __device__ __forceinline__ s16x4 tr_read(int vb) {
  s16x4 r; asm volatile("ds_read_b64_tr_b16 %0, %1 offset:%2" : "=&v"(r) : "v"(vb), "i"(OFF) : "memory"); return r;
}
template <int D0> __device__ __forceinline__ void pv_one(f32x16& od, int vb, bf16x8 pa0, bf16x8 pa1, bf16x8 pa2, bf16x8 pa3) {
  const s16x4 l0 = tr_read<v_rd_off(D0, 0, 0)>(vb), h0 = tr_read<v_rd_off(D0, 0, 1)>(vb), l1 = tr_read<v_rd_off(D0, 1, 0)>(vb), h1 = tr_read<v_rd_off(D0, 1, 1)>(vb);
  const s16x4 l2 = tr_read<v_rd_off(D0, 2, 0)>(vb), h2 = tr_read<v_rd_off(D0, 2, 1)>(vb), l3 = tr_read<v_rd_off(D0, 3, 0)>(vb), h3 = tr_read<v_rd_off(D0, 3, 1)>(vb);
  asm volatile("s_waitcnt lgkmcnt(0)" ::: "memory"); SBAR();
#define PK(L, H) (bf16x8){L[0], L[1], L[2], L[3], H[0], H[1], H[2], H[3]}
  od = __builtin_amdgcn_mfma_f32_32x32x16_bf16(pa0, PK(l0, h0), od, 0, 0, 0);
  od = __builtin_amdgcn_mfma_f32_32x32x16_bf16(pa1, PK(l1, h1), od, 0, 0, 0);
  od = __builtin_amdgcn_mfma_f32_32x32x16_bf16(pa2, PK(l2, h2), od, 0, 0, 0);
  od = __builtin_amdgcn_mfma_f32_32x32x16_bf16(pa3, PK(l3, h3), od, 0, 0, 0);
#undef PK
}
__device__ __forceinline__ void pv_d0(f32x16* o, int vb, bf16x8 pa0, bf16x8 pa1, bf16x8 pa2, bf16x8 pa3) {
  pv_one<0>(o[0], vb, pa0, pa1, pa2, pa3); pv_one<1>(o[1], vb, pa0, pa1, pa2, pa3); pv_one<2>(o[2], vb, pa0, pa1, pa2, pa3); pv_one<3>(o[3], vb, pa0, pa1, pa2, pa3);
}
__device__ __forceinline__ const void* rfl64(const void* p) { const unsigned long long v = (unsigned long long)p; const unsigned lo = __builtin_amdgcn_readfirstlane((unsigned)v), hi = __builtin_amdgcn_readfirstlane((unsigned)(v >> 32)); return (const void*)(((unsigned long long)hi << 32) | lo); }
__device__ __forceinline__ void attn_dense_body(const bf16_t* Qb, const bf16_t* Kh, const bf16_t* Vh, bf16_t* Ob, int seq, char* lds, const int tid,
                                                const float* __restrict__ qg_, const float* __restrict__ ropeT_, const int tok0) {
  Qb = (const bf16_t*)rfl64(Qb); Kh = (const bf16_t*)rfl64(Kh); Vh = (const bf16_t*)rfl64(Vh); Ob = (bf16_t*)rfl64(Ob);
  const float* qg = (const float*)rfl64(qg_); const float* ropeT = (const float*)rfl64(ropeT_);
  int tid_ = tid; asm volatile("" : "+v"(tid_));
  const int wid = tid_ >> 6, lane = tid_ & 63, r32 = lane & 31, hi = lane >> 5;
  bf16_t* V_lds = (bf16_t*)lds; bf16_t* K_lds = (bf16_t*)(lds + 2 * SHM_V);
  float* ws = (float*)(lds + 2 * SHM_V + 2 * SHM_K) + wid * 64; float* li_l = ws; float* al_l = ws + 32;
  float m_reg = -1e30f, l_reg = 0; f32x16 o[4] = {}; bf16x8 qr[8];
  const unsigned qoff = (unsigned)((wid * QBLK + r32) * LDQ + hi * 8) * 2u;
#pragma unroll
  for (int d0 = 0; d0 < 8; ++d0) qr[d0] = *reinterpret_cast<const bf16x8*>((const char*)Qb + qoff + d0 * 32);
  {
    float ss = 0.f;
#pragma unroll
    for (int d0 = 0; d0 < 8; ++d0) { const u32x4 w = *reinterpret_cast<const u32x4*>(&qr[d0]);
#pragma unroll
      for (int e = 0; e < 4; ++e) { const float a = bf_lo(w[e]), b = bf_hi(w[e]); ss += a * a + b * b; } }
    ss += shx(ss, 32);
    const float rs = __builtin_amdgcn_rsqf(ss * (1.f / 128.f) + 1e-6f);
    const int trow = tok0 + wid * QBLK + r32;
#pragma unroll
    for (int hh = 0; hh < 2; ++hh) { const float* Tp = ropeT + (hh ? (trow & 63) : (trow >> 6)) * 64 + hi * 8;
#pragma unroll
      for (int dd = 0; dd < 2; ++dd) { const int d0 = hh * 4 + dd; const u32x4 w1 = *reinterpret_cast<const u32x4*>(&qr[d0]), w2 = *reinterpret_cast<const u32x4*>(&qr[d0 + 2]);
        const float* g1 = qg + d0 * 16 + hi * 8; const float* Tc = Tp + dd * 16; float o1[8], o2[8];
#pragma unroll
        for (int e = 0; e < 8; ++e) { const float x1 = ((e & 1) ? bf_hi(w1[e >> 1]) : bf_lo(w1[e >> 1])) * rs * g1[e], x2 = ((e & 1) ? bf_hi(w2[e >> 1]) : bf_lo(w2[e >> 1])) * rs * g1[32 + e];
          const float cs = Tc[e], sn = Tc[32 + e]; o1[e] = x1 * cs - x2 * sn; o2[e] = x2 * cs + x1 * sn; }
        u32x4 p1, p2;
#pragma unroll
        for (int e = 0; e < 4; ++e) { p1[e] = cvt_pk_bf16(o1[2 * e], o1[2 * e + 1]); p2[e] = cvt_pk_bf16(o2[2 * e], o2[2 * e + 1]); }
        qr[d0] = *reinterpret_cast<bf16x8*>(&p1); qr[d0 + 2] = *reinterpret_cast<bf16x8*>(&p2); } }
  }
  const int sr = tid_ >> 4, sc = (tid_ & 15) * 8, vst0 = v_st(sr, sc), vst1 = v_st(32 + sr, sc);
  const int vb0 = (int)(uintptr_t)V_lds + v_rd_base(lane);
  struct { bf16x8 vs0, vs1, ks0, ks1; } sr_[2];
  const unsigned kvoff = (unsigned)(sr * LDK + sc) * 2u;
#define SLOAD(i, k0) do { const unsigned o0_ = kvoff + (unsigned)(k0) * (LDK * 2), o1_ = o0_ + 32 * LDK * 2; \
    sr_[i].vs0 = *(const bf16x8*)((const char*)Vh + o0_); sr_[i].vs1 = *(const bf16x8*)((const char*)Vh + o1_); \
    sr_[i].ks0 = *(const bf16x8*)((const char*)Kh + o0_); sr_[i].ks1 = *(const bf16x8*)((const char*)Kh + o1_); } while (0)
#define SWRITE(b, i) do { *(bf16x8*)((char*)V_lds + (b) * SHM_V + vst0) = sr_[i].vs0;          \
    *(bf16x8*)((char*)V_lds + (b) * SHM_V + vst1) = sr_[i].vs1; int kc = sc * 2;               \
    *(bf16x8*)((char*)K_lds + (b) * SHM_K + KSWZ(sr, kc)) = sr_[i].ks0;                       \
    *(bf16x8*)((char*)K_lds + (b) * SHM_K + KSWZ(32 + sr, kc)) = sr_[i].ks1; } while (0)
#define SWAIT() asm volatile("s_waitcnt vmcnt(4)" ::: "memory")
#define RESC(a) do { if (__any((a) < 1.f)) { if (hi == 0) al_l[r32] = (a); asm volatile("s_waitcnt lgkmcnt(0)" ::: "memory"); \
    for (int d = 0; d < 4; ++d) for (int r = 0; r < 16; ++r) o[d][r] *= al_l[crow(r, hi)]; } } while (0)
  f32x16 pA0, pA1, pB0, pB1; float mnA, mnB, alA, alB; bf16x8 pa0, pa1, pa2, pa3; const int NT = seq / KVBLK;
  constexpr int SE = 0, SO = 1;
  SLOAD(SE, 0); asm volatile("s_waitcnt vmcnt(0)" ::: "memory"); SWRITE(0, SE); __syncthreads();
  qkt(pA0, pA1, K_lds, qr, r32, hi); partialSM(pA0, pA1, m_reg, mnA, alA);
  SLOAD(SO, KVBLK); if (2 < NT) SLOAD(SE, 2 * KVBLK);
  SWAIT(); SWRITE(1, SO); __syncthreads();
  for (int j = 1; j + 1 < NT; j += 2) {
    SBAR(); qkt(pB0, pB1, (bf16_t*)((char*)K_lds + SHM_K), qr, r32, hi);
    finishSM(pA0, pA1, alA, l_reg, pa0, pa1, pa2, pa3); SBAR();
    SLOAD(SO, (j + 2) * KVBLK); SBAR();
    pv_d0(o, vb0, pa0, pa1, pa2, pa3); partialSM(pB0, pB1, m_reg, mnB, alB);
    __syncthreads(); SWAIT(); SWRITE(0, SE);
    RESC(alB); __syncthreads();
    SBAR(); qkt(pA0, pA1, K_lds, qr, r32, hi);
    finishSM(pB0, pB1, alB, l_reg, pa0, pa1, pa2, pa3); SBAR();
    if (j + 3 < NT) SLOAD(SE, (j + 3) * KVBLK); SBAR();
    pv_d0(o, vb0 + (int)SHM_V, pa0, pa1, pa2, pa3); partialSM(pA0, pA1, m_reg, mnA, alA);
    __syncthreads(); SWAIT(); SWRITE(1, SO);
    RESC(alA); __syncthreads();
  }
  SBAR(); qkt(pB0, pB1, (bf16_t*)((char*)K_lds + SHM_K), qr, r32, hi);
  finishSM(pA0, pA1, alA, l_reg, pa0, pa1, pa2, pa3); SBAR();
  pv_d0(o, vb0, pa0, pa1, pa2, pa3); partialSM(pB0, pB1, m_reg, mnB, alB);
  __syncthreads(); RESC(alB);
  finishSM(pB0, pB1, alB, l_reg, pa0, pa1, pa2, pa3); SBAR();
  pv_d0(o, vb0 + (int)SHM_V, pa0, pa1, pa2, pa3);
  if (hi == 0) li_l[r32] = l_reg; asm volatile("s_waitcnt lgkmcnt(0)" ::: "memory");
  float rli[16];
#pragma unroll
  for (int r = 0; r < 16; ++r) rli[r] = __builtin_amdgcn_rcpf(li_l[crow(r, hi)]);
  const unsigned ooff = (unsigned)((wid * QBLK + 4 * hi) * LDO + r32) * 2u;
#pragma unroll
  for (int r = 0; r < 16; ++r) { const int orow = (r & 3) + 8 * (r >> 2);
    for (int d0 = 0; d0 < 4; ++d0) *(bf16_t*)((char*)Ob + ooff + (orow * LDO + d0 * 32) * 2) = (bf16_t)(cvt_pk_bf16(o[d0][r] * rli[r], 0.f) & 0xffffu); }
#undef SLOAD
#undef SWRITE
#undef SWAIT
#undef RESC
}
#undef SBAR
}


#define XB_TMO      128
#define XB_XCNT(j)  (256  + 64 * (j))
#define XB_XSUB(j)  (1280 + 64 * (j))
#define XB_XGEN(j)  (2304 + 64 * (j))
#define XB_TOP      3328
#define XB_TOPGEN   3392
#define XCD_BAR_WORDS 3456
#define XB_SPIN_CAP (1u << 23)
__device__ __forceinline__ unsigned xb_ld(unsigned* p)              { return __hip_atomic_load(p, __ATOMIC_RELAXED, __HIP_MEMORY_SCOPE_AGENT); }
__device__ __forceinline__ unsigned xb_add(unsigned* p, unsigned v) { return __hip_atomic_fetch_add(p, v, __ATOMIC_RELAXED, __HIP_MEMORY_SCOPE_AGENT); }
__device__ __forceinline__ unsigned xb_xcc_id() { return (unsigned)__builtin_amdgcn_s_getreg((3 << 11) | 20) & 0xFu; }
#define XB_SPIN(cond, bar) do { unsigned _sp = 0; while (cond) { __builtin_amdgcn_s_sleep(1); \
    if ((++_sp & 255u) == 0u) { if (xb_ld(&(bar)[XB_TMO])) break; if (_sp > XB_SPIN_CAP) { atomicAdd(&(bar)[XB_TMO], 1u); break; } } } } while (0)
__device__ __forceinline__ void xcd_barrier_complete(unsigned* bar, unsigned x, unsigned& nloc, unsigned& nx) {
    const unsigned G = gridDim.x * gridDim.y * gridDim.z;
    unsigned sum, cnt, mine, sp = 0u;
    for (;;) {
        sum = 0u; cnt = 0u; mine = 0u;
#pragma unroll
        for (unsigned j = 0; j < 16; ++j) { const unsigned c = xb_ld(&bar[XB_XCNT(j)]); sum += c; cnt += (c > 0u) ? 1u : 0u; mine = (j == x) ? c : mine; }
        if (sum == G) break;
        __builtin_amdgcn_s_sleep(1);
        if ((++sp & 255u) == 0u) { if (xb_ld(&bar[XB_TMO])) break; if (sp > XB_SPIN_CAP) { atomicAdd(&bar[XB_TMO], 1u); break; } }
    }
    nloc = mine > 0u ? mine : 1u; nx = cnt > 0u ? cnt : 1u;
}
__device__ __forceinline__ void xcd_barrier(unsigned* bar, volatile LAS unsigned* st) {
    asm volatile("s_waitcnt vmcnt(0)" ::: "memory");
    __syncthreads();
    if (threadIdx.x == 0) {
        const unsigned x = xb_xcc_id();
        __builtin_amdgcn_s_waitcnt(0);
        unsigned nloc = st[0], nx = st[1];
        if (nloc == 0u) { xcd_barrier_complete(bar, x, nloc, nx); st[0] = nloc; st[1] = nx; }
        const unsigned old = xb_add(&bar[XB_XSUB(x)], 1u);
        const unsigned gen = old / nloc;
        if (old + 1u == (gen + 1u) * nloc) {
            __builtin_amdgcn_fence(__ATOMIC_RELEASE, "agent");
            asm volatile("s_waitcnt vmcnt(0)" ::: "memory");
            const unsigned og = xb_add(&bar[XB_TOP], 1u);
            const unsigned tg = og / nx;
            if (og + 1u == (tg + 1u) * nx) xb_add(&bar[XB_TOPGEN], 1u);
            else XB_SPIN(xb_ld(&bar[XB_TOPGEN]) == tg, bar);
            __builtin_amdgcn_fence(__ATOMIC_ACQUIRE, "agent");
            xb_add(&bar[XB_XGEN(x)], 1u);
            asm volatile("s_waitcnt vmcnt(0)" ::: "memory");
        } else {
            XB_SPIN(xb_ld(&bar[XB_XGEN(x)]) == gen, bar);
            __builtin_amdgcn_fence(__ATOMIC_ACQUIRE, "agent");
            asm volatile("s_waitcnt vmcnt(0)" ::: "memory");
        }
    }
    __syncthreads();
}
struct Args { const float* in[25]; float* out; unsigned char* ws; int ph_lo, ph_hi; };
typedef const __attribute__((address_space(4))) Args* KArgs;
enum { IN_X = 0, IN_MEM, IN_MIXG, IN_WIN, IN_QG, IN_KG, IN_CONVW, IN_CONVB, IN_LWR, IN_LBR, IN_LWI, IN_LBI, IN_LAM, IN_WA, IN_WR, IN_WMIX, IN_CROSSG, IN_MEMG,
       IN_WXQ, IN_WXKV, IN_WXO, IN_MLPG, IN_WUP, IN_WDOWN, IN_FING };

__device__ __forceinline__ void cvt_tile(const float* __restrict__ W, int N, bf16_t* __restrict__ WT, int ldk, const float* __restrict__ gain, float sc, LAS float* scr, int item, int lane) {
    const int nblk = N >> 6, kb = item / nblk, nb = item - kb * nblk, k0 = kb * 64, n0 = nb * 64;
    const int l16 = lane & 15, l4 = lane >> 4;
#pragma unroll 4
    for (int i = 0; i < 16; ++i) { const int kk = 4 * i + l4; f32x4 v = *(const f32x4*)(W + (size_t)(k0 + kk) * N + n0 + 4 * l16);
        const float g = gain ? gain[k0 + kk] * sc : sc; v = v * g;
        LAS float* d = scr + kk * 65 + 4 * l16; d[0] = v[0]; d[1] = v[1]; d[2] = v[2]; d[3] = v[3]; }
    LDS_WAIT(); asm volatile("" ::: "memory");
    const int c = lane & 7;
#pragma unroll
    for (int j = 0; j < 8; ++j) { const int n = (lane >> 3) + 8 * j; const LAS float* s = scr + (8 * c) * 65 + n;
        u32x4 o; o.x = cvt_pk_bf16(s[0 * 65], s[1 * 65]); o.y = cvt_pk_bf16(s[2 * 65], s[3 * 65]); o.z = cvt_pk_bf16(s[4 * 65], s[5 * 65]); o.w = cvt_pk_bf16(s[6 * 65], s[7 * 65]);
        *(u32x4*)(WT + (size_t)(n0 + n) * ldk + k0 + 8 * c) = o; }
    LDS_WAIT(); asm volatile("" ::: "memory");
}

__device__ __forceinline__ float gelu_tanh(float y) { const float z = 0.7978845608028654f * (y + 0.044715f * y * y * y); return y * fast_sigmoid(2.0f * z); }

__device__ __forceinline__ void lru_sweep_item(LAS unsigned char* lds, KArgs args, int l, int item, int tid, int lane, int w, bf16_t* Yout) {
    unsigned char* ws = args->ws;
    const int b = item >> 6, n = (item >> 2) & 15, dq = item & 3;
    LAS unsigned char* UFB = lds;
    LAS float* UF32 = (LAS float*)(lds + 32768);
    LAS float* Z = (LAS float*)(lds + 49152);
    LAS float* SEG = (LAS float*)(lds + 81920);
    LAS float* CAR = (LAS float*)(lds + 86016);
    const size_t rowbase = (size_t)b * SEQ;
    const bf16_t* U = (const bf16_t*)(ws + WS_U);
    const bf16_t* Y = (const bf16_t*)(ws + WS_Y);
    float* HF = (float*)(ws + WS_HF);
    const int cgp = tid & 15, tq = tid >> 4, cch = n * 128 + cgp * 8;
    f32x4 cw0[4], cw1[4], cb0, cb1;
    { const float* cw = args->in[IN_CONVW] + (size_t)l * 4 * DM + cch; const float* cb = args->in[IN_CONVB] + (size_t)l * DM + cch;
#pragma unroll
      for (int t = 0; t < 4; ++t) { cw0[t] = *(const f32x4*)(cw + t * DM); cw1[t] = *(const f32x4*)(cw + t * DM + 4); }
      cb0 = *(const f32x4*)cb; cb1 = *(const f32x4*)(cb + 4); }
    const bool own32 = (cgp >> 2) == dq;
    const int ech = tid & 31, tg = tid >> 5, chg = n * 128 + dq * 32 + ech;
    const int rt = w & 3, mat = w >> 2, r32 = lane & 31, hi = lane >> 5;
    const bf16_t* LW = (const bf16_t*)(ws + WS_W + W_LRU);
    for (int dir = 0; dir < 2; ++dir) {
        bf16x8 bfr[8];
        { const bf16_t* wp = LW + ((size_t)((mat * 2 + dir) * 16 + n) * 128 + dq * 32 + r32) * 128 + hi * 8;
#pragma unroll
          for (int ks = 0; ks < 8; ++ks) bfr[ks] = *(const bf16x8*)(wp + ks * 16); }
        const float brv = args->in[IN_LBR][(size_t)(l * 2 + dir) * DM + chg] * -1.4426950408889634f, biv = args->in[IN_LBI][(size_t)(l * 2 + dir) * DM + chg] * -1.4426950408889634f;
        const float lam = args->in[IN_LAM][(size_t)(l * 2 + dir) * DM + chg];
        const float sp = softplus_neg(lam);
        const float c1 = -8.0f * sp * 1.4426950408889634f, c2 = -16.0f * sp;
        const bool small = __all(16.0f * sp < 0.3f);
        if (tid < 64) CAR[tid] = 0.f;
        u32x4 ur[7];
#define LRU_LOADROWS(cc) do { _Pragma("unroll") for (int j = 0; j < 7; ++j) { const int t = (cc) * 128 + 4 * tq - 2 + j; \
            ur[j] = (t >= 0 && t < SEQ) ? *(const u32x4*)(U + (rowbase + t) * DM + cch) : (u32x4){0u, 0u, 0u, 0u}; } } while (0)
        LRU_LOADROWS(dir ? 31 : 0);
        for (int k = 0; k < 32; ++k) {
            const int c = dir ? 31 - k : k, t0 = c * 128;
            {
                f32x4 o0[4], o1[4];
#pragma unroll
                for (int i = 0; i < 4; ++i) { o0[i] = cb0; o1[i] = cb1; }
#pragma unroll
                for (int j = 0; j < 7; ++j) { const u32x4 q = ur[j]; const f32x4 r0 = {bf_lo(q.x), bf_hi(q.x), bf_lo(q.y), bf_hi(q.y)}, r1 = {bf_lo(q.z), bf_hi(q.z), bf_lo(q.w), bf_hi(q.w)};
#pragma unroll
                    for (int i = 0; i < 4; ++i) { const int tap = j - i; if (tap >= 0 && tap < 4) { o0[i] += r0 * cw0[tap]; o1[i] += r1 * cw1[tap]; } } }
#pragma unroll
                for (int i = 0; i < 4; ++i) { const int row = 4 * tq + i; u32x4 pk; pk.x = cvt_pk_bf16(o0[i][0], o0[i][1]); pk.y = cvt_pk_bf16(o0[i][2], o0[i][3]); pk.z = cvt_pk_bf16(o1[i][0], o1[i][1]); pk.w = cvt_pk_bf16(o1[i][2], o1[i][3]);
                    *(LAS u32x4*)(UFB + row * 256 + ((cgp * 16) ^ ((row & 7) << 4))) = pk;
                    if (own32) { LAS float* d = UF32 + row * 32 + (cgp & 3) * 8; *(LAS f32x4*)d = o0[i]; *(LAS f32x4*)(d + 4) = o1[i]; } }
            }
            if (k + 1 < 32) LRU_LOADROWS(dir ? 30 - k : k + 1);
            __syncthreads();
            {
                f32x16 acc = {};
#pragma unroll
                for (int ks = 0; ks < 8; ++ks) { const int row = rt * 32 + r32; const bf16x8 a = *(const LAS bf16x8*)(UFB + row * 256 + (((ks * 16 + hi * 8) * 2) ^ ((row & 7) << 4)));
                    acc = __builtin_amdgcn_mfma_f32_32x32x16_bf16(a, bfr[ks], acc, 0, 0, 0); }
#pragma unroll
                for (int r = 0; r < 16; ++r) Z[(mat * 128 + rt * 32 + att::crow(r, hi)) * 32 + r32] = acc[r];
            }
            __syncthreads();
            float av[8], bv[8], hfv[8], yv[8];
            if (dir) {
#pragma unroll
                for (int j = 0; j < 8; ++j) { const int tok = 127 - (tg * 8 + j); const size_t gi = (rowbase + t0 + tok) * DM + chg; hfv[j] = HF[gi]; yv[j] = bf1(Y[gi]); } }
            float Ap = 1.f, Hh = 0.f;
#pragma unroll
            for (int j = 0; j < 8; ++j) { const int p = tg * 8 + j, tok = dir ? 127 - p : p;
                const float zr = Z[tok * 32 + ech], zi = Z[(128 + tok) * 32 + ech], uf = UF32[tok * 32 + ech];
                const float er = __builtin_amdgcn_exp2f(fmaf(zr, -1.4426950408889634f, brv)), ei = __builtin_amdgcn_exp2f(fmaf(zi, -1.4426950408889634f, biv));
                const float rg = __builtin_amdgcn_rcpf(1.0f + er), ig = __builtin_amdgcn_rcpf(1.0f + ei);
                const float a = __builtin_amdgcn_exp2f(c1 * rg), x2 = c2 * rg;
                float oma2 = -x2 * (1.0f + x2 * (0.5f + x2 * (0.16666667f + x2 * (0.041666668f + x2 * (0.0083333338f + x2 * 0.0013888889f)))));
                if (!small) oma2 = (x2 > -0.3f) ? oma2 : (1.0f - a * a);
                const float bt = __builtin_amdgcn_sqrtf(oma2) * ig * uf;
                av[j] = a; bv[j] = bt; Hh = a * Hh + bt; Ap *= a; }
            SEG[(tg * 32 + ech) * 2] = Ap; SEG[(tg * 32 + ech) * 2 + 1] = Hh;
            __syncthreads();
            {
                float h = CAR[(k & 1) * 32 + ech];
#pragma unroll
                for (int s = 0; s < 15; ++s) { const f32x2 sg = *(const LAS f32x2*)(SEG + (s * 32 + ech) * 2); h = (s < tg) ? sg.x * h + sg.y : h; }
#pragma unroll
                for (int j = 0; j < 8; ++j) { const int p = tg * 8 + j, tok = dir ? 127 - p : p; const size_t gi = (rowbase + t0 + tok) * DM + chg; h = av[j] * h + bv[j];
                    if (dir == 0) HF[gi] = h;
                    else { const float o = (h + hfv[j]) * gelu_tanh(yv[j]); Yout[gi] = (bf16_t)(cvt_pk_bf16(o, 0.f) & 0xffffu); } }
                if (tg == 15) CAR[((k + 1) & 1) * 32 + ech] = h;
            }
        }
#undef LRU_LOADROWS
        asm volatile("s_waitcnt vmcnt(0)" ::: "memory"); __syncthreads();
        __builtin_amdgcn_fence(__ATOMIC_ACQUIRE, "agent");
    }
}
__device__ __forceinline__ void lru_sweep2_item(LAS unsigned char* lds, KArgs args, int l, int item, int tid, int lane, int w, bf16_t* Yout) {
    unsigned char* ws = args->ws;
    const int b = item >> 6, n = (item >> 2) & 15, dq = item & 3;
    LAS unsigned char* UFB = lds;
    LAS float* Z = (LAS float*)(lds + 65536);
    LAS float* SEG = (LAS float*)(lds + 131072);
    LAS float* CAR = (LAS float*)(lds + 139264);
    LAS float* CW = (LAS float*)(lds + 139776);
    const size_t rowbase = (size_t)b * SEQ;
    const bf16_t* U = (const bf16_t*)(ws + WS_U);
    const bf16_t* Y = (const bf16_t*)(ws + WS_Y);
    float* HS = (float*)(ws + WS_HF);
    const int rt = w & 3, mat = w >> 2;
    const int tq = tid >> 4, cch = n * 128 + (tid & 15) * 8, chg = n * 128 + dq * 32 + (tid & 31);
    for (int i = tid; i < 640; i += 512) CW[i] = (i < 512) ? args->in[IN_CONVW][(size_t)l * 4 * DM + (size_t)(i >> 7) * DM + n * 128 + (i & 127)] : args->in[IN_CONVB][(size_t)l * DM + n * 128 + (i & 127)];
    if (tid < 128) CAR[tid] = 0.f;
    const bf16_t* LW = (const bf16_t*)(ws + WS_W + W_LRU);
    float brv[2], biv[2], c1[2], c2[2]; bool small = true;
#pragma unroll
    for (int dir = 0; dir < 2; ++dir) { brv[dir] = args->in[IN_LBR][(size_t)(l * 2 + dir) * DM + chg] * -1.4426950408889634f; biv[dir] = args->in[IN_LBI][(size_t)(l * 2 + dir) * DM + chg] * -1.4426950408889634f;
        const float lam = args->in[IN_LAM][(size_t)(l * 2 + dir) * DM + chg]; const float sp = softplus_neg(lam);
        c1[dir] = -8.0f * sp * 1.4426950408889634f; c2[dir] = -16.0f * sp; small = small && (16.0f * sp < 0.3f); }
    small = __all(small);
    u32x4 ur[2][7];
#define LRU_LOADROWS(d, cc) do { int tb_ = (cc) * 128 + 4 * tq - 2; asm volatile("" : "+v"(tb_));     \
        const unsigned ob_ = (unsigned)(((int)rowbase + tb_) * DM + cch) * 2u; \
        _Pragma("unroll") for (int j = 0; j < 7; ++j) { const bool ok_ = (unsigned)(tb_ + j) < (unsigned)SEQ; \
            ur[d][j] = ok_ ? *(const u32x4*)((const char*)U + (ob_ + (unsigned)j * (unsigned)(DM * 2))) : (u32x4){0u, 0u, 0u, 0u}; } } while (0)
    LRU_LOADROWS(0, 0); LRU_LOADROWS(1, 31);
    __syncthreads();
    for (int k = 0; k < 32; ++k) {
        const bool fin = k >= 16;
        const int t_ = w * 64 + CUR_LANE();
        const int cgp = t_ & 15, tq = t_ >> 4, cch = n * 128 + cgp * 8, ech = t_ & 31, tg = t_ >> 5, chg = n * 128 + dq * 32 + ech, ecol = dq * 32 + ech, r32 = t_ & 31, hi = (t_ >> 5) & 1;
        bf16x8 bfr[2][8];
#pragma unroll
        for (int dir = 0; dir < 2; ++dir) { const bf16_t* wp = LW + ((size_t)((mat * 2 + dir) * 16 + n) * 128 + dq * 32 + r32) * 128 + hi * 8;
#pragma unroll
            for (int ks = 0; ks < 8; ++ks) bfr[dir][ks] = *(const bf16x8*)(wp + ks * 16); }
        {
            f32x4 cw0[4], cw1[4];
#pragma unroll
            for (int t = 0; t < 4; ++t) { cw0[t] = *(const LAS f32x4*)(CW + t * 128 + cgp * 8); cw1[t] = *(const LAS f32x4*)(CW + t * 128 + cgp * 8 + 4); }
            const f32x4 cb0 = *(const LAS f32x4*)(CW + 512 + cgp * 8), cb1 = *(const LAS f32x4*)(CW + 512 + cgp * 8 + 4);
#pragma unroll
            for (int dir = 0; dir < 2; ++dir) {
                f32x4 o0[4], o1[4];
#pragma unroll
                for (int i = 0; i < 4; ++i) { o0[i] = cb0; o1[i] = cb1; }
#pragma unroll
                for (int j = 0; j < 7; ++j) { const u32x4 q = ur[dir][j]; const f32x4 r0 = {bf_lo(q.x), bf_hi(q.x), bf_lo(q.y), bf_hi(q.y)}, r1 = {bf_lo(q.z), bf_hi(q.z), bf_lo(q.w), bf_hi(q.w)};
#pragma unroll
                    for (int i = 0; i < 4; ++i) { const int tap = j - i; if (tap >= 0 && tap < 4) { o0[i] += r0 * cw0[tap]; o1[i] += r1 * cw1[tap]; } } }
#pragma unroll
                for (int i = 0; i < 4; ++i) { const int row = 4 * tq + i; u32x4 pk; pk.x = cvt_pk_bf16(o0[i][0], o0[i][1]); pk.y = cvt_pk_bf16(o0[i][2], o0[i][3]); pk.z = cvt_pk_bf16(o1[i][0], o1[i][1]); pk.w = cvt_pk_bf16(o1[i][2], o1[i][3]);
                    *(LAS u32x4*)(UFB + dir * 32768 + row * 256 + ((cgp * 16) ^ ((row & 7) << 4))) = pk; }
            }
        }
        if (k >= 15) asm volatile("s_waitcnt vmcnt(0)" ::: "memory");
        if (k + 1 < 32) { LRU_LOADROWS(0, k + 1); LRU_LOADROWS(1, 30 - k); }
        __syncthreads();
#pragma unroll
        for (int dir = 0; dir < 2; ++dir) {
            f32x16 acc = {};
#pragma unroll
            for (int ks = 0; ks < 8; ++ks) { const int row = rt * 32 + r32; const bf16x8 a = *(const LAS bf16x8*)(UFB + dir * 32768 + row * 256 + (((ks * 16 + hi * 8) * 2) ^ ((row & 7) << 4)));
                acc = __builtin_amdgcn_mfma_f32_32x32x16_bf16(a, bfr[dir][ks], acc, 0, 0, 0); }
#pragma unroll
            for (int r = 0; r < 16; ++r) Z[((dir * 2 + mat) * 128 + rt * 32 + att::crow(r, hi)) * 32 + r32] = acc[r];
        }
        __syncthreads();
        float av[2][8], bv[2][8], hsv[2][8], yv[2][8];
        if (fin) {
#pragma unroll
            for (int dir = 0; dir < 2; ++dir) { const int t0 = (dir ? 31 - k : k) * 128;
                unsigned oh = (unsigned)(((rowbase + t0 + (dir ? 127 - tg * 8 : tg * 8)) * DM + chg) * 4);
#pragma unroll
                for (int j = 0; j < 8; ++j) { hsv[dir][j] = *(const float*)((const char*)HS + oh); yv[dir][j] = bf1(*(const bf16_t*)((const char*)Y + (oh >> 1))); oh += dir ? (unsigned)(-DM * 4) : (unsigned)(DM * 4); asm volatile("" : "+v"(oh)); } } }
#pragma unroll
        for (int dir = 0; dir < 2; ++dir) { float Ap = 1.f, Hh = 0.f;
#pragma unroll
            for (int j = 0; j < 8; ++j) { const int p = tg * 8 + j, tok = dir ? 127 - p : p;
                const float zr = Z[((dir * 2 + 0) * 128 + tok) * 32 + ech], zi = Z[((dir * 2 + 1) * 128 + tok) * 32 + ech];
                const float uf = bf1(*(const LAS bf16_t*)(UFB + dir * 32768 + tok * 256 + ((((ecol >> 3) << 4) ^ ((tok & 7) << 4)) + (ecol & 7) * 2)));
                const float er = __builtin_amdgcn_exp2f(fmaf(zr, -1.4426950408889634f, brv[dir])), ei = __builtin_amdgcn_exp2f(fmaf(zi, -1.4426950408889634f, biv[dir]));
                const float rg = __builtin_amdgcn_rcpf(1.0f + er), ig = __builtin_amdgcn_rcpf(1.0f + ei);
                const float a = __builtin_amdgcn_exp2f(c1[dir] * rg), x2 = c2[dir] * rg;
                float oma2 = -x2 * (1.0f + x2 * (0.5f + x2 * (0.16666667f + x2 * (0.041666668f + x2 * (0.0083333338f + x2 * 0.0013888889f)))));
                if (!small) oma2 = (x2 > -0.3f) ? oma2 : (1.0f - a * a);
                const float bt = __builtin_amdgcn_sqrtf(oma2) * ig * uf;
                av[dir][j] = a; bv[dir][j] = bt; Hh = a * Hh + bt; Ap *= a; }
            *(LAS f32x2*)(SEG + ((dir * 16 + tg) * 32 + ech) * 2) = (f32x2){Ap, Hh}; }
        __syncthreads();
#pragma unroll
        for (int dir = 0; dir < 2; ++dir) {
            const int t0 = (dir ? 31 - k : k) * 128;
            float h = CAR[(dir * 2 + (k & 1)) * 32 + ech];
            f32x2 sgv[15];
#pragma unroll
            for (int s = 0; s < 15; ++s) sgv[s] = *(const LAS f32x2*)(SEG + ((dir * 16 + s) * 32 + ech) * 2);
            asm volatile("s_waitcnt lgkmcnt(0)" ::: "memory"); __builtin_amdgcn_sched_barrier(0);
#pragma unroll
            for (int s = 0; s < 15; ++s) { const float ae = (s < tg) ? sgv[s].x : 1.0f, he = (s < tg) ? sgv[s].y : 0.0f; h = fmaf(ae, h, he); }
            unsigned oh = (unsigned)(((rowbase + t0 + (dir ? 127 - tg * 8 : tg * 8)) * DM + chg) * 4);
#pragma unroll
            for (int j = 0; j < 8; ++j) { h = av[dir][j] * h + bv[dir][j];
                if (!fin) *(float*)((char*)HS + oh) = h;
                else { const float o = (h + hsv[dir][j]) * gelu_tanh(yv[dir][j]); *(bf16_t*)((char*)Yout + (oh >> 1)) = (bf16_t)(cvt_pk_bf16(o, 0.f) & 0xffffu); }
                oh += dir ? (unsigned)(-DM * 4) : (unsigned)(DM * 4); asm volatile("" : "+v"(oh)); }
            if (tg == 15) CAR[(dir * 2 + ((k + 1) & 1)) * 32 + ech] = h;
        }
    }
#undef LRU_LOADROWS
    asm volatile("s_waitcnt vmcnt(0)" ::: "memory"); __syncthreads();
}
__device__ __forceinline__ void lru_sweep3_item(LAS unsigned char* lds, KArgs args, int l, int item, int tid, int abl, int w, bf16_t* Yout) {
    unsigned char* ws = args->ws;
    const int b = item >> 6, n = (item >> 2) & 15, dq = item & 3;
    LAS unsigned char* UFB = lds;
    LAS float* Z = (LAS float*)(lds + 65536);
    LAS float* SEG = (LAS float*)(lds + 131072);
    LAS float* CAR = (LAS float*)(lds + 139264);
    LAS float* CW = (LAS float*)(lds + 139776);
    const size_t rowbase = (size_t)b * SEQ;
    const bf16_t* U = (const bf16_t*)(ws + WS_U);
    const bf16_t* Y = (const bf16_t*)(ws + WS_Y);
    float* HS = (float*)(ws + WS_HF);
    const int rt = w & 3, mat = w >> 2;
    const int chg = n * 128 + dq * 32 + (tid & 31);
    if (tid < 128) CAR[tid] = 0.f;
    const bf16_t* LW = (const bf16_t*)(ws + WS_W + W_LRU);
    float brv[2], biv[2], c1[2], c2[2]; bool small = true;
#pragma unroll
    for (int dir = 0; dir < 2; ++dir) { brv[dir] = args->in[IN_LBR][(size_t)(l * 2 + dir) * DM + chg] * -1.4426950408889634f; biv[dir] = args->in[IN_LBI][(size_t)(l * 2 + dir) * DM + chg] * -1.4426950408889634f;
        const float lam = args->in[IN_LAM][(size_t)(l * 2 + dir) * DM + chg]; const float sp = softplus_neg(lam);
        c1[dir] = -8.0f * sp * 1.4426950408889634f; c2[dir] = -16.0f * sp; small = small && (16.0f * sp < 0.3f); }
    small = __all(small);
    const bf16_t* UFG = (const bf16_t*)(ws + WS_UF);
#define LRU_DMA(kk) do { _Pragma("unroll") for (int dir_ = 0; dir_ < 2; ++dir_) { const int c0_ = (dir_ ? 31 - (kk) : (kk)) * 128; \
        _Pragma("unroll") for (int i_ = 0; i_ < 4; ++i_) { const int ln_ = CUR_LANE(), row_ = (i_ * 8 + w) * 4 + (ln_ >> 4), cs_ = (ln_ & 15) ^ (row_ & 7); \
            __builtin_amdgcn_global_load_lds((const unsigned*)(UFG + (rowbase + c0_ + row_) * DM + n * 128 + cs_ * 8), (LAS unsigned*)(UFB + dir_ * 32768 + (i_ * 8 + w) * 1024), 16, 0, 0); } } } while (0)
    bf16x8 bfr[2][8];
#define LRU_LOADW() do { const int ln_ = CUR_LANE(); _Pragma("unroll") for (int dir_ = 0; dir_ < 2; ++dir_) { const bf16_t* wp_ = LW + ((size_t)((mat * 2 + dir_) * 16 + n) * 128 + dq * 32 + (ln_ & 31)) * 128 + (ln_ >> 5) * 8; \
        _Pragma("unroll") for (int ks_ = 0; ks_ < 8; ++ks_) bfr[dir_][ks_] = *(const bf16x8*)(wp_ + ks_ * 16); } } while (0)
    LRU_LOADW();
    LRU_DMA(0);
    asm volatile("s_waitcnt vmcnt(0)" ::: "memory");
    __syncthreads();
    for (int k = 0; k < 32; ++k) {
        const bool fin = k >= 16;
        const int t_ = w * 64 + CUR_LANE();
        const int ech = t_ & 31, tg = t_ >> 5, chg = n * 128 + dq * 32 + ech, ecol = dq * 32 + ech, r32 = t_ & 31, hi = (t_ >> 5) & 1;
        if (k > 0) { asm volatile("s_waitcnt vmcnt(0)" ::: "memory"); __syncthreads(); }
        if (!(abl & 1))
#pragma unroll
        for (int dir = 0; dir < 2; ++dir) {
            f32x16 acc = {};
#pragma unroll
            for (int ks = 0; ks < 8; ++ks) { const int row = rt * 32 + r32; const bf16x8 a = *(const LAS bf16x8*)(UFB + dir * 32768 + row * 256 + (((ks * 16 + hi * 8) * 2) ^ ((row & 7) << 4)));
                acc = __builtin_amdgcn_mfma_f32_32x32x16_bf16(a, bfr[dir][ks], acc, 0, 0, 0); }
#pragma unroll
            for (int r = 0; r < 16; ++r) Z[((dir * 2 + mat) * 128 + rt * 32 + att::crow(r, hi)) * 32 + r32] = acc[r];
        }
        float ufv[2][8];
#pragma unroll
        for (int dir = 0; dir < 2; ++dir)
#pragma unroll
            for (int j = 0; j < 8; ++j) { const int p = tg * 8 + j, tok = dir ? 127 - p : p; ufv[dir][j] = bf1(*(const LAS bf16_t*)(UFB + dir * 32768 + tok * 256 + ((((ecol >> 3) << 4) ^ ((tok & 7) << 4)) + (ecol & 7) * 2))); }
        asm volatile("s_waitcnt lgkmcnt(0)" ::: "memory");
        __syncthreads();
        if (k + 1 < 32) LRU_DMA(k + 1);
        float av[2][8], bv[2][8], hsv[2][8], yv[2][8];
        if (fin && !(abl & 8)) {
#pragma unroll
            for (int dir = 0; dir < 2; ++dir) { const int t0 = (dir ? 31 - k : k) * 128;
                unsigned oh = (unsigned)(((rowbase + t0 + (dir ? 127 - tg * 8 : tg * 8)) * DM + chg) * 4);
#pragma unroll
                for (int j = 0; j < 8; ++j) { hsv[dir][j] = *(const float*)((const char*)HS + oh); yv[dir][j] = bf1(*(const bf16_t*)((const char*)Y + (oh >> 1))); oh += dir ? (unsigned)(-DM * 4) : (unsigned)(DM * 4); asm volatile("" : "+v"(oh)); } } }
        if (abl & 2) {
#pragma unroll
            for (int dir = 0; dir < 2; ++dir)
#pragma unroll
                for (int j = 0; j < 8; ++j) { av[dir][j] = 1.f; bv[dir][j] = ufv[dir][j]; }
        } else
#pragma unroll
        for (int dir = 0; dir < 2; ++dir) { float Ap = 1.f, Hh = 0.f;
#pragma unroll
            for (int j = 0; j < 8; ++j) { const int p = tg * 8 + j, tok = dir ? 127 - p : p;
                const float zr = Z[((dir * 2 + 0) * 128 + tok) * 32 + ech], zi = Z[((dir * 2 + 1) * 128 + tok) * 32 + ech];
                const float uf = ufv[dir][j];
                const float er = __builtin_amdgcn_exp2f(fmaf(zr, -1.4426950408889634f, brv[dir])), ei = __builtin_amdgcn_exp2f(fmaf(zi, -1.4426950408889634f, biv[dir]));
                const float rg = __builtin_amdgcn_rcpf(1.0f + er), ig = __builtin_amdgcn_rcpf(1.0f + ei);
                const float a = __builtin_amdgcn_exp2f(c1[dir] * rg), x2 = c2[dir] * rg;
                float oma2 = -x2 * (1.0f + x2 * (0.5f + x2 * (0.16666667f + x2 * (0.041666668f + x2 * (0.0083333338f + x2 * 0.0013888889f)))));
                if (!small) oma2 = (x2 > -0.3f) ? oma2 : (1.0f - a * a);
                const float bt = __builtin_amdgcn_sqrtf(oma2) * ig * uf;
                av[dir][j] = a; bv[dir][j] = bt; Hh = a * Hh + bt; Ap *= a; }
            *(LAS f32x2*)(SEG + ((dir * 16 + tg) * 32 + ech) * 2) = (f32x2){Ap, Hh}; }
        __syncthreads();
        if (!(abl & 4))
#pragma unroll
        for (int dir = 0; dir < 2; ++dir) {
            const int t0 = (dir ? 31 - k : k) * 128;
            float h = CAR[(dir * 2 + (k & 1)) * 32 + ech];
            f32x2 sgv[15];
#pragma unroll
            for (int s = 0; s < 15; ++s) sgv[s] = *(const LAS f32x2*)(SEG + ((dir * 16 + s) * 32 + ech) * 2);
            asm volatile("s_waitcnt lgkmcnt(0)" ::: "memory"); __builtin_amdgcn_sched_barrier(0);
#pragma unroll
            for (int s = 0; s < 15; ++s) { const float ae = (s < tg) ? sgv[s].x : 1.0f, he = (s < tg) ? sgv[s].y : 0.0f; h = fmaf(ae, h, he); }
            unsigned oh = (unsigned)(((rowbase + t0 + (dir ? 127 - tg * 8 : tg * 8)) * DM + chg) * 4);
#pragma unroll
            for (int j = 0; j < 8; ++j) { h = av[dir][j] * h + bv[dir][j];
                if (!fin) *(float*)((char*)HS + oh) = h;
                else { const float o = (h + hsv[dir][j]) * gelu_tanh(yv[dir][j]); *(bf16_t*)((char*)Yout + (oh >> 1)) = (bf16_t)(cvt_pk_bf16(o, 0.f) & 0xffffu); }
                oh += dir ? (unsigned)(-DM * 4) : (unsigned)(DM * 4); asm volatile("" : "+v"(oh)); }
            if (tg == 15) CAR[(dir * 2 + ((k + 1) & 1)) * 32 + ech] = h;
        }
    }
#undef LRU_DMA
#undef LRU_LOADW
    asm volatile("s_waitcnt vmcnt(0)" ::: "memory"); __syncthreads();
}
struct SchedMemKV { int G, c; const char* MN; const char* WK; const char* WV; unsigned char* ws;
                __device__ __forceinline__ bool next(int i, pg8::Unit& u) const { const int idx = i * G + c; if (idx >= 64) return false; u.sub = 0;
                    if (idx < 32) { u.pm = idx >> 3; u.pn = idx & 7; u.a = MN + (size_t)u.pm * 256 * DM * 2; u.b = WK + (size_t)u.pn * 256 * DM * 2; }
                    else { const int j = idx - 32; u.pm = 8 + (j >> 2); u.pn = j & 3; u.a = WV + (size_t)(j >> 2) * 256 * DM * 2; u.b = MN + (size_t)u.pn * 256 * DM * 2; }
                    return true; } };
              struct EpiMemKV { static constexpr bool AFTER_DRAIN = false, ACCUM2 = false; bf16_t* KO; bf16_t* VO;
                __device__ __forceinline__ void operator()(PG8_ACC, const pg8::Unit& u, int wr, int wc, int fr, int fq) const {
                    const bool isv = u.pm >= 8; const int ldc = isv ? MMEM : DM, pm = isv ? u.pm - 8 : u.pm;
                    bf16_t* base = (isv ? VO : KO) + (size_t)(pm * 256 + wr * 64 + fr) * ldc + u.pn * 256 + wc * 32 + 8 * fq;
#pragma unroll
                    for (int ai = 0; ai < 2; ++ai)
#pragma unroll
                        for (int m = 0; m < 4; ++m)
#pragma unroll
                            for (int bj = 0; bj < 2; ++bj) store8_bf16(base + (size_t)(ai * 128 + m * 16) * ldc + bj * 128, acc[ai][bj][m][0], acc[ai][bj][m][1]); } };
            struct SchedX2 { int G, c; const char* P; const char* VT;
                __device__ __forceinline__ bool next(int i, pg8::Unit& u) const { const int idx = i * G + c; if (idx >= 512) return false;
                    const int b = idx >> 7, qb = (idx >> 3) & 15, h = (idx >> 1) & 3, nt = idx & 1; u.pm = b * 16 + qb; u.pn = h * 2 + nt; u.sub = 0;
                    u.a = P + ((size_t)(b * SEQ + qb * 256) * 1024 + h * 256) * 2; u.b = VT + ((size_t)(h * 512 + nt * 256) * MMEM + b * NMEM) * 2; return true; } };

__global__ void __launch_bounds__(512, 2) hybrid_fwd(Args kargs) {
    extern __shared__ __attribute__((aligned(16))) unsigned char lds_raw[];
    LAS unsigned char* lds = (LAS unsigned char*)lds_raw;
    cg::grid_group grid = cg::this_grid();
    const int ph_lo = kargs.ph_lo, ph_hi = kargs.ph_hi;
    volatile LAS unsigned* bar_st = (volatile LAS unsigned*)(lds + LDS_BYTES - 64);
    if (threadIdx.x == 0) { bar_st[0] = 0u; bar_st[1] = 0u; if (ph_hi - ph_lo > 1) (void)xb_add((unsigned*)(kargs.ws + WS_BAR) + XB_XCNT(xb_xcc_id()), 1u); }
    __syncthreads();
    const int wave0 = __builtin_amdgcn_readfirstlane(threadIdx.x >> 6);
    const int st_hi = ph_hi + ((PROBE_Q >= 0 && ph_hi > PROBE_Q) ? PROBE_N : 0);
    for (int st = ph_lo; st < st_hi; ++st) {
        const bool dmy = (PROBE_Q >= 0) && st > PROBE_Q && st <= PROBE_Q + PROBE_N;
        const int ph = (PROBE_Q >= 0 && st > PROBE_Q) ? (dmy ? PROBE_Q : st - PROBE_N) : st;
        KArgs args = (KArgs)__builtin_amdgcn_kernarg_segment_ptr();
        asm volatile("" : "+s"(args));
        int wave = wave0; asm volatile("" : "+s"(wave));
        int bx = blockIdx.x; asm volatile("" : "+s"(bx));
        const int G = gridDim.x;
        const int vcu = (G % 8 == 0) ? (bx % 8) * (G / 8) + bx / 8 : bx;
        const int gw = vcu * 8 + wave, NGW = G * 8;
#define TID() (wave * 64 + CUR_LANE())
        unsigned char* ws = args->ws;
        u64* rowss = (u64*)(ws + WS_ROWSS);
        bf16_t* XB = (bf16_t*)(ws + WS_XB);
        float* xres = args->out;
        const int l = ph / NPH_LAYER, q = (ph == NPH - 1) ? 99 : ph % NPH_LAYER;
        unsigned char* wl = ws + WS_W;
        if (PHM(0) && q == 0) {
            const int lane = CUR_LANE();
            LAS float* scr = (LAS float*)(lds + wave * 16640);
            constexpr int I_IN = (DM / 64) * (NIN / 64), I_SQ = (DM / 64) * (DM / 64), I_KV = (DM / 64) * (2 * DM / 64), I_UP = (DM / 64) * (FF / 64), I_DN = I_UP, I_LRU = 2 * 2 * 16 * 4;
            constexpr int NITEMS = I_IN + 5 * I_SQ + I_KV + I_UP + I_DN + I_LRU;
            const size_t sq = (size_t)DM * DM;
            for (int it = gw; it < NITEMS; it += NGW) {
                int r = it;
                if (r < I_IN) { cvt_tile(args->in[IN_WIN] + (size_t)l * DM * NIN, NIN, (bf16_t*)(wl + W_IN), DM, args->in[IN_MIXG] + l * DM, 1.f, scr, r, lane); continue; } r -= I_IN;
                if (r < I_SQ) { cvt_tile(args->in[IN_WA] + l * sq, DM, (bf16_t*)(wl + W_A), DM, nullptr, 1.f, scr, r, lane); continue; } r -= I_SQ;
                if (r < I_SQ) { cvt_tile(args->in[IN_WR] + l * sq, DM, (bf16_t*)(wl + W_R), DM, nullptr, 1.f, scr, r, lane); continue; } r -= I_SQ;
                if (r < I_SQ) { cvt_tile(args->in[IN_WMIX] + l * sq, DM, (bf16_t*)(wl + W_MIX), DM, nullptr, 1.f, scr, r, lane); continue; } r -= I_SQ;
                if (r < I_SQ) { cvt_tile(args->in[IN_WXQ] + l * sq, DM, (bf16_t*)(wl + W_XQ), DM, args->in[IN_CROSSG] + l * DM, 0.044194173824159216f, scr, r, lane); continue; } r -= I_SQ;
                if (r < I_SQ) { cvt_tile(args->in[IN_WXO] + l * sq, DM, (bf16_t*)(wl + W_XO), DM, nullptr, 1.f, scr, r, lane); continue; } r -= I_SQ;
                if (r < I_KV) { cvt_tile(args->in[IN_WXKV] + l * 2 * sq, 2 * DM, (bf16_t*)(wl + W_XKV), DM, nullptr, 1.f, scr, r, lane); continue; } r -= I_KV;
                if (r < I_UP) { cvt_tile(args->in[IN_WUP] + (size_t)l * DM * FF, FF, (bf16_t*)(wl + W_UP), DM, args->in[IN_MLPG] + l * DM, 1.f, scr, r, lane); continue; } r -= I_UP;
                if (r < I_DN) { cvt_tile(args->in[IN_WDOWN] + (size_t)l * DM * FF, DM, (bf16_t*)(wl + W_DOWN), FF, nullptr, 1.f, scr, r, lane); continue; } r -= I_DN;
                { const int mat = r >> 7, rr = r & 127, dn = rr >> 2, t4 = rr & 3;
                  const float* src = args->in[mat ? IN_LWI : IN_LWR] + ((size_t)(l * 2) * 16 + dn) * 16384;
                  cvt_tile(src, 128, (bf16_t*)(wl + W_LRU) + ((size_t)mat * 32 + dn) * 16384, 128, nullptr, 1.f, scr, t4, lane); }
            }
            for (int m = gw; m < MMEM; m += NGW) { const f32x4* xr = (const f32x4*)(args->in[IN_MEM] + (size_t)m * DM) + lane; const f32x4* gr = (const f32x4*)(args->in[IN_MEMG] + l * DM) + lane;
                f32x4 v[8]; float s = 0.f;
#pragma unroll
                for (int j = 0; j < 8; ++j) { v[j] = xr[64 * j]; s += (v[j].x * v[j].x + v[j].y * v[j].y) + (v[j].z * v[j].z + v[j].w * v[j].w); }
                const float rs = __builtin_amdgcn_rsqf(wave_sum(s) * (1.f / DM) + EPS);
                u32x2* o8 = (u32x2*)((bf16_t*)(ws + WS_MN) + (size_t)m * DM) + lane;
#pragma unroll
                for (int j = 0; j < 8; ++j) { const f32x4 g = gr[64 * j]; u32x2 o; o.x = cvt_pk_bf16(v[j].x * rs * g.x, v[j].y * rs * g.y); o.y = cvt_pk_bf16(v[j].z * rs * g.z, v[j].w * rs * g.w); o8[64 * j] = o; } }
            if (l == 0) {
                for (int m = gw; m < MT; m += NGW) { const f32x4* xr = (const f32x4*)(args->in[IN_X] + (size_t)m * DM) + lane;
                    f32x4 v[8]; float s = 0.f;
#pragma unroll
                    for (int j = 0; j < 8; ++j) { v[j] = xr[64 * j]; s += (v[j].x * v[j].x + v[j].y * v[j].y) + (v[j].z * v[j].z + v[j].w * v[j].w); }
                    s = wave_sum(s); if (lane == 0) rowss[m] = f_to_ss(s);
                    u32x2* o8 = (u32x2*)(XB + (size_t)m * DM) + lane;
#pragma unroll
                    for (int j = 0; j < 8; ++j) { u32x2 o; o.x = cvt_pk_bf16(v[j].x, v[j].y); o.y = cvt_pk_bf16(v[j].z, v[j].w); o8[64 * j] = o; } }
                const int gt = bx * 512 + wave * 64 + lane;
                if (gt < 2048) { const int pos = gt >> 5, i = gt & 31; const float inv = __builtin_amdgcn_exp2f(-(float)i * (13.287712379549449f / 32.0f));
                    const float rev = (float)pos * inv * 0.15915494309189535f; float* T = (float*)(ws + WS_ROPE) + pos * 64;
                    T[i] = __builtin_amdgcn_cosf(rev); T[32 + i] = __builtin_amdgcn_sinf(rev); }
            }
        } else if (PHM(1) && (q == 1)) {
            pg8::SchedPlain S; S.o.init(MT, NIN, G, bx); S.A = (const char*)XB; S.B = (const char*)(wl + W_IN); S.tA = (size_t)256 * DM * 2; S.tB = (size_t)256 * DM * 2;
            pg8::EpiG1 E{ws, rowss + (size_t)(3 * l) * MT};
            pg8::gemm_phase<pg8::EpiG1, pg8::SchedPlain, true>(lds, TID(), DM, DM, DM, S, E);
        } else if (PHM(2) && (q == 2)) {
            if (PHM(13) && (!dmy || (PROBE_SUB & 1))) {
              SchedMemKV S{G, bx, (const char*)(ws + WS_MN), (const char*)(wl + W_XKV), (const char*)(wl + W_XKV + (size_t)DM * DM * 2), ws};
              EpiMemKV E{(bf16_t*)(ws + WS_MEMK), (bf16_t*)(ws + WS_MEMVT)};
              pg8::gemm_phase<EpiMemKV, SchedMemKV, true>(lds, TID(), DM, DM, DM, S, E); }
            __syncthreads();
            const int nsk = (G >= 128) ? 64 : 0;
            const int tgw = (bx - nsk) * 8 + wave, TNGW = (G - nsk) * 8;
            if (PHM(12) && !dmy && bx >= nsk) {
                const int lane = CUR_LANE(), cgp = lane & 15, tq = lane >> 4;
                const bf16_t* U = (const bf16_t*)(ws + WS_U); bf16_t* UFo = (bf16_t*)(ws + WS_UF);
                for (int it = tgw; it < (MT / 16) * 16; it += TNGW) { const int nb = it & 15, r0 = (it >> 4) * 16 + 4 * tq, cch = nb * 128 + cgp * 8, tl = (r0 & (SEQ - 1)) - 2;
                    const float* cw = args->in[IN_CONVW] + (size_t)l * 4 * DM + cch; const float* cb = args->in[IN_CONVB] + (size_t)l * DM + cch;
                    f32x4 cw0[4], cw1[4];
#pragma unroll
                    for (int t = 0; t < 4; ++t) { cw0[t] = *(const f32x4*)(cw + t * DM); cw1[t] = *(const f32x4*)(cw + t * DM + 4); }
                    const f32x4 cb0 = *(const f32x4*)cb, cb1 = *(const f32x4*)(cb + 4);
                    u32x4 ur[7];
#pragma unroll
                    for (int j = 0; j < 7; ++j) ur[j] = ((unsigned)(tl + j) < (unsigned)SEQ) ? *(const u32x4*)(U + (size_t)(r0 - 2 + j) * DM + cch) : (u32x4){0u, 0u, 0u, 0u};
                    f32x4 o0[4], o1[4];
#pragma unroll
                    for (int i = 0; i < 4; ++i) { o0[i] = cb0; o1[i] = cb1; }
#pragma unroll
                    for (int j = 0; j < 7; ++j) { const u32x4 q4 = ur[j]; const f32x4 r0v = {bf_lo(q4.x), bf_hi(q4.x), bf_lo(q4.y), bf_hi(q4.y)}, r1v = {bf_lo(q4.z), bf_hi(q4.z), bf_lo(q4.w), bf_hi(q4.w)};
#pragma unroll
                        for (int i = 0; i < 4; ++i) { const int tap = j - i; if (tap >= 0 && tap < 4) { o0[i] += r0v * cw0[tap]; o1[i] += r1v * cw1[tap]; } } }
#pragma unroll
                    for (int i = 0; i < 4; ++i) store8_bf16(UFo + (size_t)(r0 + i) * DM + cch, o0[i], o1[i]); }
            }
            if (PHM(12) && !dmy && bx >= nsk) {
                const int lane = CUR_LANE();
                const int j = lane & 7, half = j >> 2, c4 = j & 3; const float* T = (const float*)(ws + WS_ROPE);
                bf16_t* Kp = (bf16_t*)(ws + WS_K);
                for (int v = tgw * 8 + (lane >> 3); v < MT * 4; v += TNGW * 8) { const int m = v >> 2, hh = v & 3;
                    bf16_t* p = Kp + (size_t)m * 512 + hh * 128;
                    const float* g = args->in[IN_KG] + l * 128 + 64 * half + 8 * c4;
                    p += 64 * half + 8 * c4;
                    const u32x4 ua = *(const u32x4*)p, ub = *(const u32x4*)(p + 32);
                    float a[8], bb[8];
#pragma unroll
                    for (int e = 0; e < 4; ++e) { a[2 * e] = bf_lo(ua[e]); a[2 * e + 1] = bf_hi(ua[e]); bb[2 * e] = bf_lo(ub[e]); bb[2 * e + 1] = bf_hi(ub[e]); }
                    float ss = 0.f;
#pragma unroll
                    for (int e = 0; e < 8; ++e) ss += a[e] * a[e] + bb[e] * bb[e];
                    ss += shx(ss, 1); ss += shx(ss, 2); ss += shx(ss, 4);
                    const float rs = __builtin_amdgcn_rsqf(ss * (1.f / 128.f) + EPS);
                    const int t = m & (SEQ - 1), pos = half ? (t & 63) : (t >> 6);
                    const float* Tc = T + pos * 64 + 8 * c4;
                    float oa[8], ob[8];
#pragma unroll
                    for (int e = 0; e < 8; ++e) { const float x1 = a[e] * rs * g[e], x2 = bb[e] * rs * g[32 + e], cs = Tc[e], sn = Tc[32 + e]; oa[e] = x1 * cs - x2 * sn; ob[e] = x2 * cs + x1 * sn; }
                    u32x4 wa, wb;
#pragma unroll
                    for (int e = 0; e < 4; ++e) { wa[e] = cvt_pk_bf16(oa[2 * e], oa[2 * e + 1]); wb[e] = cvt_pk_bf16(ob[2 * e], ob[2 * e + 1]); }
                    *(u32x4*)p = wa; *(u32x4*)(p + 32) = wb; }
            }
        } else if (PHM(3) && (q == 3)) {
            if (PHM(10) && (!dmy || (PROBE_SUB & 2))) for (int u = vcu; u < 256; u += G) { lru_sweep3_item(lds, args, l, u, TID(), dmy ? PROBE_ABL : 0, wave, (bf16_t*)(ws + (dmy ? WS_U : WS_Y))); __syncthreads(); }
            if (PHM(11) && (!dmy || (PROBE_SUB & 1))) for (int u = vcu; u < 1024; u += G) { const int grp = u >> 6, b = grp >> 2, kvh = grp & 3, idx = u & 63, hq = kvh * 4 + (idx >> 4), qb = idx & 15;
                bf16_t* Qb = (bf16_t*)(ws + WS_Q) + ((size_t)(b * SEQ + qb * 256)) * 2048 + hq * 128;
                const bf16_t* Kh = (const bf16_t*)(ws + WS_K) + (size_t)b * SEQ * 512 + kvh * 128; const bf16_t* Vh = (const bf16_t*)(ws + WS_V) + (size_t)b * SEQ * 512 + kvh * 128;
                att::attn_dense_body(Qb, Kh, Vh, dmy ? Qb + (WS_DUMMY - WS_Q) / 2 : Qb, SEQ, (char*)lds_raw, TID(), args->in[IN_QG] + l * 128, (const float*)(ws + WS_ROPE), qb * 256);
                __syncthreads(); }
        } else if (PHM(4) && (q == 4)) {
            pg8::SchedDual S; S.o.init(MT, DM, G, bx); S.A = (const char*)(ws + WS_Q); S.B = (const char*)(wl + W_A); S.A2 = (const char*)(ws + WS_Y); S.B2 = (const char*)(wl + W_R);
            S.tA = (size_t)256 * DM * 2; S.tB = (size_t)256 * DM * 2;
            pg8::EpiGate E{(const bf16_t*)(ws + WS_GA), (const bf16_t*)(ws + WS_GR), (bf16_t*)(ws + WS_MERGED)};
            pg8::gemm_phase<pg8::EpiGate, pg8::SchedDual, true>(lds, TID(), DM, DM, DM, S, E);
        } else if (PHM(5) && (q == 5 || q == 9 || q == 11)) {
            pg8::SchedPlain S; S.o.init(MT, DM, G, bx); S.tB = (size_t)256 * DM * 2; int K = DM;
            if (q == 5) { S.A = (const char*)(ws + WS_MERGED); S.B = (const char*)(wl + W_MIX); S.tA = (size_t)256 * DM * 2; }
            else if (q == 9) { S.A = (const char*)(ws + WS_XO); S.B = (const char*)(wl + W_XO); S.tA = (size_t)256 * DM * 2; }
            else { S.A = (const char*)(ws + WS_H); S.B = (const char*)(wl + W_DOWN); S.tA = (size_t)256 * FF * 2; S.tB = (size_t)256 * FF * 2; K = FF; }
            const int ridx = (q == 5) ? 3 * l + 1 : (q == 9) ? 3 * l + 2 : 3 * l + 3;
            pg8::EpiRes E{XB, (q == 11 && l == 1) ? xres : nullptr, rowss + (size_t)ridx * MT};
            pg8::gemm_phase<pg8::EpiRes, pg8::SchedPlain, false>(lds, TID(), K, K, K, S, E);
        } else if (PHM(6) && (q == 6 || q == 10)) {
            pg8::SchedPlain S; S.A = (const char*)XB; S.tA = (size_t)256 * DM * 2; S.tB = (size_t)256 * DM * 2;
            S.o.init(MT, q == 6 ? DM : FF, G, bx); S.B = (const char*)(wl + (q == 6 ? W_XQ : W_UP));
            pg8::EpiRow1 E{(bf16_t*)(ws + (q == 6 ? WS_XQ : WS_H)), q == 6 ? DM : FF, rowss + (size_t)(3 * l + (q == 6 ? 1 : 2)) * MT, q == 6 ? 0 : 1};
            pg8::gemm_phase<pg8::EpiRow1, pg8::SchedPlain, true>(lds, TID(), DM, DM, DM, S, E);
        } else if (PHM(7) && (q == 7)) {
            for (int u = vcu; u < 256; u += G) { const int b = u >> 6, h = (u >> 4) & 3, qb = u & 15;
                pg8::SchedOne S; S.u.pm = b * 16 + qb; S.u.pn = h; S.u.sub = 0;
                S.u.a = (const char*)(ws + WS_XQ) + ((size_t)(b * SEQ + qb * 256) * DM + h * 512) * 2; S.u.b = (const char*)(ws + WS_MEMK) + ((size_t)(b * NMEM) * DM + h * 512) * 2;
                pg8::EpiSoftmax E{(bf16_t*)(ws + WS_P), 1024};
                pg8::gemm_phase<pg8::EpiSoftmax, pg8::SchedOne, false>(lds, TID(), 512, DM, DM, S, E);
                __syncthreads(); }
        } else if (PHM(8) && (q == 8)) {
            SchedX2 S{G, vcu, (const char*)(ws + WS_P), (const char*)(ws + WS_MEMVT)};
            pg8::EpiPlain E{(bf16_t*)(ws + WS_XO), DM};
            pg8::gemm_phase<pg8::EpiPlain, SchedX2, true>(lds, TID(), 256, 1024, MMEM, S, E);
        } else if (PHM(9) && (q == 99)) {
            const int lane = CUR_LANE();
            const u64* rs6 = rowss + (size_t)6 * MT;
            for (int m = gw; m < MT; m += NGW) { f32x4* xr = (f32x4*)(xres + (size_t)m * DM) + lane; const f32x4* gr = (const f32x4*)args->in[IN_FING] + lane;
                const float rs = __builtin_amdgcn_rsqf(ss_to_f(rs6[m]) * (1.f / DM) + EPS);
#pragma unroll
                for (int j = 0; j < 8; ++j) { const f32x4 v = xr[64 * j], g = gr[64 * j]; xr[64 * j] = v * rs * g; } }
        }
        if (st + 1 < st_hi) {
            if (ph_hi > 1000000) grid.sync();
            xcd_barrier((unsigned*)(ws + WS_BAR), bar_st);
            for (int e = 0; e < PROBE_SYNC; ++e) xcd_barrier((unsigned*)(ws + WS_BAR), bar_st); }
    }
}

extern "C" void kernel_launch(void* const* d_in, const int* in_sizes, int n_in, void* d_out, int out_size, void* d_ws, size_t ws_size, hipStream_t stream) {
    static int grid = 0;
    if (grid == 0) {
        if (n_in != 25 || in_sizes[0] != MT * DM || out_size != MT * DM || ws_size < WS_END) { fprintf(stderr, "kernel_launch: unexpected shapes (n_in %d, ws %zu, need %zu)\n", n_in, ws_size, (size_t)WS_END); grid = -1; return; }
        int dev = 0, cus = 0, per_cu = 0;
        hipGetDevice(&dev); hipDeviceGetAttribute(&cus, hipDeviceAttributeMultiprocessorCount, dev);
        if (hipFuncSetAttribute((const void*)hybrid_fwd, hipFuncAttributeMaxDynamicSharedMemorySize, LDS_BYTES) != hipSuccess) { fprintf(stderr, "kernel_launch: hipFuncSetAttribute failed\n"); grid = -1; return; }
        if (hipOccupancyMaxActiveBlocksPerMultiprocessor(&per_cu, (const void*)hybrid_fwd, 512, LDS_BYTES) != hipSuccess || per_cu < 1) { fprintf(stderr, "kernel_launch: occupancy query says %d\n", per_cu); per_cu = 1; }
        (void)hipGetLastError();
        grid = cus;
    }
    if (grid < 0) return;
    hipMemsetAsync((char*)d_ws + WS_ROWSS, 0, CTL_BYTES, stream);
    Args a{};
    for (int i = 0; i < 25; ++i) a.in[i] = (const float*)d_in[i];
    a.out = (float*)d_out; a.ws = (unsigned char*)d_ws;
#if MK_ONE_LAUNCH
    a.ph_lo = 0; a.ph_hi = NPH;
    void* kargs[] = {&a};
    hipError_t e = hipLaunchCooperativeKernel((const void*)hybrid_fwd, dim3(grid), dim3(512), kargs, LDS_BYTES, stream);
    if (e != hipSuccess) fprintf(stderr, "kernel_launch: cooperative launch failed: %s (grid %d)\n", hipGetErrorString(e), grid);
#else
    for (int p = 0; p < NPH; ++p) { a.ph_lo = p; a.ph_hi = p + 1; hipLaunchKernelGGL(hybrid_fwd, dim3(grid), dim3(512), LDS_BYTES, stream, a); }
#endif
}
```

```cpp
#include <hip/hip_runtime.h>
#include <hip/hip_cooperative_groups.h>
#include <cstdio>
#include <cstdint>
namespace cg = cooperative_groups;

#ifndef MK_ONE_LAUNCH
#define MK_ONE_LAUNCH 1
#endif

#ifndef PH_MASK
#define PH_MASK 0xfffff
#endif
#define PHM(i) ((PH_MASK >> (i)) & 1)
#ifndef PROBE_Q
#define PROBE_Q -1
#endif
#ifndef PROBE_N
#define PROBE_N 1
#endif
#ifndef PROBE_SUB
#define PROBE_SUB 3
#endif
#ifndef PROBE_ABL
#define PROBE_ABL 0
#endif
#ifndef PROBE_SYNC
#define PROBE_SYNC 0
#endif
constexpr size_t WS_DUMMY = (size_t)604 << 20;
#define LAS __attribute__((address_space(3)))
typedef unsigned short bf16_t;
typedef short bf16x8 __attribute__((ext_vector_type(8)));
typedef short s16x4 __attribute__((ext_vector_type(4)));
typedef float f32x4 __attribute__((ext_vector_type(4)));
typedef float f32x2 __attribute__((ext_vector_type(2)));
typedef float f32x16 __attribute__((ext_vector_type(16)));
typedef unsigned u32x4 __attribute__((ext_vector_type(4)));
typedef unsigned u32x2 __attribute__((ext_vector_type(2)));

constexpr int DM = 2048, NB = 4, SEQ = 4096, MT = NB * SEQ, NIN = 11264, FF = 8192, NMEM = 256, MMEM = NB * NMEM;
constexpr float EPS = 1e-6f;
constexpr int NPH_LAYER = 12, NPH = 2 * NPH_LAYER + 1;

constexpr size_t MiB = 1u << 20;
constexpr size_t WS_ROWSS = 0;
constexpr size_t CTL_BYTES = 2 * MiB;
constexpr size_t WS_BAR = 1536 * 1024;
constexpr size_t WS_ROPE = 2 * MiB;
constexpr size_t WS_MN = 10 * MiB;
constexpr size_t WS_MEMK = 14 * MiB;
constexpr size_t WS_MEMVT = 18 * MiB;
constexpr size_t WS_W = 22 * MiB;
constexpr size_t W_IN = 0, W_A = 44 * MiB, W_R = 52 * MiB, W_MIX = 60 * MiB, W_XQ = 68 * MiB, W_XO = 76 * MiB, W_XKV = 84 * MiB,
                 W_UP = 100 * MiB, W_DOWN = 132 * MiB, W_LRU = 164 * MiB, W_END = 166 * MiB;
constexpr size_t WS_XB = WS_W + W_END;
constexpr size_t WS_Q = 252 * MiB, WS_K = 316 * MiB, WS_V = 332 * MiB, WS_U = 348 * MiB, WS_Y = 412 * MiB, WS_GA = 476 * MiB, WS_GR = 540 * MiB;
constexpr size_t WS_MERGED = WS_K;
constexpr size_t WS_XQ = WS_Q, WS_P = 380 * MiB, WS_XO = WS_Y, WS_H = WS_Q;
constexpr size_t WS_HF = 604 * MiB;
constexpr size_t WS_UF = 732 * MiB;
constexpr size_t WS_END = 796 * MiB;

constexpr int LDS_BYTES = 147456;

__device__ __forceinline__ unsigned cvt_pk_bf16(float lo, float hi) { unsigned r; asm volatile("v_cvt_pk_bf16_f32 %0, %1, %2" : "=v"(r) : "v"(lo), "v"(hi)); return r; }
__device__ __forceinline__ float bf_lo(unsigned u) { return __uint_as_float(u << 16); }
__device__ __forceinline__ float bf_hi(unsigned u) { return __uint_as_float(u & 0xffff0000u); }
__device__ __forceinline__ float bf1(bf16_t h) { return __uint_as_float(((unsigned)h) << 16); }
__device__ __forceinline__ float fast_sigmoid(float x) { return __builtin_amdgcn_rcpf(1.0f + __expf(-x)); }
#define CUR_LANE() ({ int l__; asm volatile("v_mbcnt_lo_u32_b32 %0, -1, 0\n\tv_mbcnt_hi_u32_b32 %0, -1, %0" : "=v"(l__)); l__; })
__device__ __forceinline__ float shx(float v, int m) { const int l = CUR_LANE(); return __int_as_float(__builtin_amdgcn_ds_bpermute((l ^ m) << 2, __float_as_int(v))); }
__device__ __forceinline__ float wave_sum(float v) {
    const int l = CUR_LANE();
#pragma unroll
    for (int o = 1; o < 64; o <<= 1) v += __int_as_float(__builtin_amdgcn_ds_bpermute((l ^ o) << 2, __float_as_int(v)));
    return v;
}
__device__ __forceinline__ float softplus_neg(float lam) {
    const float e = __expf(-lam);
    const float ser = e * (1.0f - e * (0.5f - e * (0.33333334f - e * (0.25f - e * 0.2f))));
    return (lam > 2.3f) ? ser : ((lam > -15.f) ? __logf(1.0f + e) : -lam);
}
__device__ __forceinline__ void store8_bf16(bf16_t* p, f32x4 v0, f32x4 v1) {
    u32x4 w; w.x = cvt_pk_bf16(v0[0], v0[1]); w.y = cvt_pk_bf16(v0[2], v0[3]); w.z = cvt_pk_bf16(v1[0], v1[1]); w.w = cvt_pk_bf16(v1[2], v1[3]);
    *(u32x4*)p = w;
}
#define LDS_WAIT() asm volatile("s_waitcnt lgkmcnt(0)" ::: "memory")
typedef unsigned long long u64;
__device__ __forceinline__ float ss_to_f(u64 v) { return (float)v * (1.0f / 16777216.0f); }
__device__ __forceinline__ u64 f_to_ss(float s) { return (u64)(s * 16777216.0f); }

namespace pg8 {
constexpr int BM = 256, BK = 64, HALF = 128, HTB = HALF * BK * 2, STAGE_BYTES = 8 * HTB, NXCD = 8, WGM = 4;
__host__ __device__ __forceinline__ int lds_byte(int r, int c) { const int st = (r >> 4) * 2 + (c >> 5), rr = r & 15, cc = c & 31, ob = rr * 64 + cc * 2; return st * 1024 + (ob ^ (((ob >> 9) & 1) << 5)); }
__host__ __device__ __forceinline__ void stage_rc(int b, int& R, int& C) { const int st = b / 1024, sb = b % 1024, swz = sb ^ (((sb >> 9) & 1) << 5); R = (st >> 1) * 16 + swz / 64; C = (st & 1) * 32 + (swz % 64) / 2; }
__host__ __device__ __forceinline__ int perm32(int rho) { const int n = rho >> 4, i = rho & 15; return 8 * (i >> 2) + 4 * n + (i & 3); }

struct Unit { int pm, pn, sub; const char* a; const char* b; };

struct TileOrder {
    int nM, nN, nwg, G, c;
    __device__ __forceinline__ void init(int M, int N, int G_, int c_) { nM = M / BM; nN = N / BM; nwg = nM * nN; G = G_; c = c_; }
    __device__ __forceinline__ bool tile(int i, int& pm, int& pn) const {
        const long L = (long)i * G + c; if (L >= nwg) return false;
        int wgid = (int)L; { const int q = nwg / NXCD, r = nwg % NXCD, xcd = wgid % NXCD, off = wgid / NXCD; wgid = (xcd < r ? xcd * (q + 1) : r * (q + 1) + (xcd - r) * q) + off; }
        const int nig = WGM * nN, gid = wgid / nig, fm = gid * WGM, gsz = (nM - fm) < WGM ? (nM - fm) : WGM;
        pm = fm + ((wgid % nig) % gsz); pn = (wgid % nig) / gsz; return true;
    }
};
struct SchedPlain {
    TileOrder o; const char* A; const char* B; size_t tA, tB;
    __device__ __forceinline__ bool next(int i, Unit& u) const { if (!o.tile(i, u.pm, u.pn)) return false; u.sub = 0; u.a = A + (size_t)u.pm * tA; u.b = B + (size_t)u.pn * tB; return true; }
};
struct SchedDual {
    TileOrder o; const char* A; const char* B; const char* A2; const char* B2; size_t tA, tB;
    __device__ __forceinline__ bool next(int i, Unit& u) const { if (!o.tile(i >> 1, u.pm, u.pn)) return false; u.sub = i & 1;
        u.a = ((i & 1) ? A2 : A) + (size_t)u.pm * tA; u.b = ((i & 1) ? B2 : B) + (size_t)u.pn * tB; return true; }
};
struct SchedOne { Unit u; __device__ __forceinline__ bool next(int i, Unit& o) const { if (i) return false; o = u; return true; } };

#define PG8_ACC f32x4 (&acc)[2][2][4][2]
struct EpiPlain {
    static constexpr bool AFTER_DRAIN = false, ACCUM2 = false;
    bf16_t* O; int ldc;
    __device__ __forceinline__ void operator()(PG8_ACC, const Unit& u, int wr, int wc, int fr, int fq) const {
        bf16_t* base = O + (size_t)(u.pm * BM + wr * 64 + fr) * ldc + u.pn * BM + wc * 32 + 8 * fq;
#pragma unroll
        for (int ai = 0; ai < 2; ++ai)
#pragma unroll
            for (int m = 0; m < 4; ++m)
#pragma unroll
                for (int bj = 0; bj < 2; ++bj) store8_bf16(base + (size_t)(ai * HALF + m * 16) * ldc + bj * HALF, acc[ai][bj][m][0], acc[ai][bj][m][1]);
    }
};
struct EpiRow1 {
    static constexpr bool AFTER_DRAIN = false, ACCUM2 = false;
    bf16_t* O; int ldc; const u64* rowss; int act;
    __device__ __forceinline__ void operator()(PG8_ACC, const Unit& u, int wr, int wc, int fr, int fq) const {
        const int row0 = u.pm * BM + wr * 64 + fr;
        bf16_t* base = O + (size_t)row0 * ldc + u.pn * BM + wc * 32 + 8 * fq;
        float rs[2][4];
#pragma unroll
        for (int ai = 0; ai < 2; ++ai)
#pragma unroll
            for (int m = 0; m < 4; ++m) rs[ai][m] = ss_to_f(rowss[row0 + ai * HALF + m * 16]);
#pragma unroll
        for (int ai = 0; ai < 2; ++ai)
#pragma unroll
            for (int m = 0; m < 4; ++m) { const float r = __builtin_amdgcn_rsqf(rs[ai][m] * (1.0f / DM) + EPS);
#pragma unroll
                for (int bj = 0; bj < 2; ++bj) { f32x4 v0 = acc[ai][bj][m][0] * r, v1 = acc[ai][bj][m][1] * r;
                    if (act) { v0 = __builtin_elementwise_max(v0, (f32x4){0.f, 0.f, 0.f, 0.f}); v1 = __builtin_elementwise_max(v1, (f32x4){0.f, 0.f, 0.f, 0.f}); v0 = v0 * v0; v1 = v1 * v1; }
                    store8_bf16(base + (size_t)(ai * HALF + m * 16) * ldc + bj * HALF, v0, v1); } }
    }
};
struct EpiG1 {
    static constexpr bool AFTER_DRAIN = false, ACCUM2 = false;
    unsigned char* ws; const u64* rowss;
    __device__ __forceinline__ void operator()(PG8_ACC, const Unit& u, int wr, int wc, int fr, int fq) const {
        const int pn = u.pn; size_t off; int ldc, ct;
        if (pn < 8) { off = WS_Q; ldc = 2048; ct = pn; } else if (pn < 10) { off = WS_K; ldc = 512; ct = pn - 8; } else if (pn < 12) { off = WS_V; ldc = 512; ct = pn - 10; }
        else if (pn < 20) { off = WS_U; ldc = 2048; ct = pn - 12; } else if (pn < 28) { off = WS_Y; ldc = 2048; ct = pn - 20; } else if (pn < 36) { off = WS_GA; ldc = 2048; ct = pn - 28; }
        else { off = WS_GR; ldc = 2048; ct = pn - 36; }
        const int row0 = u.pm * BM + wr * 64 + fr;
        bf16_t* base = (bf16_t*)(ws + off) + (size_t)row0 * ldc + ct * BM + wc * 32 + 8 * fq;
        float rs[2][4];
#pragma unroll
        for (int ai = 0; ai < 2; ++ai)
#pragma unroll
            for (int m = 0; m < 4; ++m) rs[ai][m] = ss_to_f(rowss[row0 + ai * HALF + m * 16]);
#pragma unroll
        for (int ai = 0; ai < 2; ++ai)
#pragma unroll
            for (int m = 0; m < 4; ++m) { const float r = __builtin_amdgcn_rsqf(rs[ai][m] * (1.0f / DM) + EPS);
#pragma unroll
                for (int bj = 0; bj < 2; ++bj) store8_bf16(base + (size_t)(ai * HALF + m * 16) * ldc + bj * HALF, acc[ai][bj][m][0] * r, acc[ai][bj][m][1] * r); }
    }
};
struct EpiGate {
    static constexpr bool AFTER_DRAIN = false, ACCUM2 = true;
    const bf16_t* GA; const bf16_t* GR; bf16_t* O;
    __device__ __forceinline__ void operator()(PG8_ACC, const Unit& u, int wr, int wc, int fr, int fq) const {
        const size_t o0 = (size_t)(u.pm * BM + wr * 64 + fr) * DM + u.pn * BM + wc * 32 + 8 * fq;
        const bf16_t* __restrict__ ga_ = GA; const bf16_t* __restrict__ gr_ = GR; bf16_t* __restrict__ out_ = O;
#pragma unroll
        for (int ai = 0; ai < 2; ++ai) {
            u32x4 grv[4][2], gav[4][2];
#pragma unroll
            for (int m = 0; m < 4; ++m)
#pragma unroll
                for (int bj = 0; bj < 2; ++bj) { const size_t o = o0 + (size_t)(ai * HALF + m * 16) * DM + bj * HALF; grv[m][bj] = *(const u32x4*)(gr_ + o); if (u.sub == 0) gav[m][bj] = *(const u32x4*)(ga_ + o); }
#pragma unroll
            for (int m = 0; m < 4; ++m)
#pragma unroll
                for (int bj = 0; bj < 2; ++bj) { const size_t o = o0 + (size_t)(ai * HALF + m * 16) * DM + bj * HALF;
                    const u32x4 gr = grv[m][bj]; float er[8];
#pragma unroll
                    for (int e = 0; e < 4; ++e) { er[2 * e] = 1.0f + __expf(-bf_lo(gr[e])); er[2 * e + 1] = 1.0f + __expf(-bf_hi(gr[e])); }
                    if (u.sub == 0) { const u32x4 ga = gav[m][bj];
#pragma unroll
                        for (int e = 0; e < 4; ++e) { const float a0 = 1.0f + __expf(-bf_lo(ga[e])), a1 = 1.0f + __expf(-bf_hi(ga[e]));
                            const float r0 = er[2 * e] * __builtin_amdgcn_rcpf(a0), r1 = er[2 * e + 1] * __builtin_amdgcn_rcpf(a1);
                            acc[ai][bj][m][e >> 1][(2 * e) & 3] *= r0; acc[ai][bj][m][e >> 1][(2 * e + 1) & 3] *= r1; }
                    } else { f32x4 v0, v1;
#pragma unroll
                        for (int e = 0; e < 4; ++e) { v0[e] = acc[ai][bj][m][0][e] * __builtin_amdgcn_rcpf(er[e]); v1[e] = acc[ai][bj][m][1][e] * __builtin_amdgcn_rcpf(er[4 + e]); }
                        store8_bf16(out_ + o, v0, v1); } }
        }
    }
};
struct EpiRes {
    static constexpr bool AFTER_DRAIN = false, ACCUM2 = false;
    bf16_t* XB; float* out32; u64* rowss;
    __device__ __forceinline__ void operator()(PG8_ACC, const Unit& u, int wr, int wc, int fr, int fq) const {
        const int row0 = u.pm * BM + wr * 64 + fr;
        const size_t o0 = (size_t)row0 * DM + u.pn * BM + wc * 32 + 8 * fq;
#pragma unroll
        for (int ai = 0; ai < 2; ++ai) {
            u32x4 xv[4][2];
#pragma unroll
            for (int m = 0; m < 4; ++m)
#pragma unroll
                for (int bj = 0; bj < 2; ++bj) xv[m][bj] = *(const u32x4*)(XB + o0 + (size_t)(ai * HALF + m * 16) * DM + bj * HALF);
#pragma unroll
            for (int m = 0; m < 4; ++m) { float ss = 0.f;
#pragma unroll
                for (int bj = 0; bj < 2; ++bj) { const size_t o = o0 + (size_t)(ai * HALF + m * 16) * DM + bj * HALF; const u32x4 q = xv[m][bj];
                    const f32x4 v0 = (f32x4){bf_lo(q.x), bf_hi(q.x), bf_lo(q.y), bf_hi(q.y)} + acc[ai][bj][m][0], v1 = (f32x4){bf_lo(q.z), bf_hi(q.z), bf_lo(q.w), bf_hi(q.w)} + acc[ai][bj][m][1];
                    if (out32) { *(f32x4*)(out32 + o) = v0; *(f32x4*)(out32 + o + 4) = v1; } else store8_bf16(XB + o, v0, v1);
                    ss += (v0[0] * v0[0] + v0[1] * v0[1]) + (v0[2] * v0[2] + v0[3] * v0[3]) + (v1[0] * v1[0] + v1[1] * v1[1]) + (v1[2] * v1[2] + v1[3] * v1[3]); }
                ss += shx(ss, 16); ss += shx(ss, 32);
                if (fq == 0) atomicAdd(rowss + row0 + ai * HALF + m * 16, f_to_ss(ss)); }
        }
    }
};
struct EpiSoftmax {
    static constexpr bool AFTER_DRAIN = true, ACCUM2 = false;
    bf16_t* O; int ldc;
    __device__ __forceinline__ void operator()(PG8_ACC, const Unit&, int, int, int, int) const {}
    __device__ __forceinline__ void fused(PG8_ACC, const Unit& u, int wr, int wc, int fr, int fq, LAS unsigned char* lds) const {
        LAS float* PM = (LAS float*)lds; LAS float* PS = (LAS float*)(lds + 4096);
#pragma unroll
        for (int ai = 0; ai < 2; ++ai)
#pragma unroll
            for (int m = 0; m < 4; ++m) { float mx = -3.0e38f;
#pragma unroll
                for (int bj = 0; bj < 2; ++bj)
#pragma unroll
                    for (int n = 0; n < 2; ++n) { const f32x4 x = acc[ai][bj][m][n]; mx = fmaxf(mx, fmaxf(fmaxf(x[0], x[1]), fmaxf(x[2], x[3]))); }
                mx = fmaxf(mx, shx(mx, 16)); mx = fmaxf(mx, shx(mx, 32));
                if (fq == 0) PM[(ai * HALF + wr * 64 + m * 16 + fr) * 4 + wc] = mx; }
        LDS_WAIT(); __builtin_amdgcn_s_barrier(); asm volatile("" ::: "memory");
#pragma unroll
        for (int ai = 0; ai < 2; ++ai)
#pragma unroll
            for (int m = 0; m < 4; ++m) { const int r = ai * HALF + wr * 64 + m * 16 + fr; const f32x4 q = *(const LAS f32x4*)(PM + r * 4);
                const float mm = fmaxf(fmaxf(q[0], q[1]), fmaxf(q[2], q[3])) * 1.4426950408889634f; float s = 0.f;
#pragma unroll
                for (int bj = 0; bj < 2; ++bj)
#pragma unroll
                    for (int n = 0; n < 2; ++n)
#pragma unroll
                        for (int e = 0; e < 4; ++e) { const float p = __builtin_amdgcn_exp2f(acc[ai][bj][m][n][e] * 1.4426950408889634f - mm); acc[ai][bj][m][n][e] = p; s += p; }
                s += shx(s, 16); s += shx(s, 32);
                if (fq == 0) PS[r * 4 + wc] = s; }
        LDS_WAIT(); __builtin_amdgcn_s_barrier(); asm volatile("" ::: "memory");
        bf16_t* base = O + (size_t)(u.pm * BM + wr * 64 + fr) * ldc + u.pn * BM + wc * 32 + 8 * fq;
#pragma unroll
        for (int ai = 0; ai < 2; ++ai)
#pragma unroll
            for (int m = 0; m < 4; ++m) { const int r = ai * HALF + wr * 64 + m * 16 + fr; const f32x4 q = *(const LAS f32x4*)(PS + r * 4);
                const float inv = __builtin_amdgcn_rcpf((q[0] + q[1]) + (q[2] + q[3]));
#pragma unroll
                for (int bj = 0; bj < 2; ++bj) store8_bf16(base + (size_t)(ai * HALF + m * 16) * ldc + bj * HALF, acc[ai][bj][m][0] * inv, acc[ai][bj][m][1] * inv); }
        LDS_WAIT(); __builtin_amdgcn_s_barrier(); asm volatile("" ::: "memory");
    }
};

template <class Epi, class Sched, bool ALIGN_EPI>
__device__ __forceinline__ void gemm_phase(LAS unsigned char* lds, const int tid, const int K, const int lda, const int ldb, const Sched& S, const Epi& E) {
    const int wid = __builtin_amdgcn_readfirstlane(tid >> 6), lane = tid & 63, wr = wid >> 2, wc = wid & 3, fr = lane & 15, fq = lane >> 4;
    const int nt = K / BK;
    unsigned voffA[2], voffB[2];
#pragma unroll
    for (int i = 0; i < 2; ++i) { int R, C; stage_rc(tid * 16 + i * 8192, R, C); const int Rb = (R & ~31) + perm32(R & 31);
        voffA[i] = (unsigned)(R * lda + C) * 2u; voffB[i] = (unsigned)(Rb * ldb + C) * 2u; }
    const size_t kstep = (size_t)(BK * 2);
    const size_t hstepA = (size_t)HALF * lda * 2, hstepB = (size_t)HALF * ldb * 2;
    const unsigned ldsw = (unsigned)wid * 1024u;
    const int aoff = lds_byte(wr * 64 + fr, fq * 8), boff = lds_byte(wc * 32 + fr, fq * 8);
#define PG8_SA(b, h) (((b) * 2 + (h)) * HTB)
#define PG8_SB(b, h) ((4 + (b) * 2 + (h)) * HTB)
#define PG8_STAGE(bufoff, gbase, voff) do { _Pragma("unroll") for (int _i = 0; _i < 2; ++_i) \
        __builtin_amdgcn_global_load_lds((const unsigned*)((const char*)(gbase) + (voff)[_i]), (LAS unsigned*)(lds + (bufoff) + ldsw + _i * 8192), 16, 0, 0); } while (0)
#define PG8_LDA(dst, b, h) do { _Pragma("unroll") for (int m = 0; m < 4; ++m) _Pragma("unroll") for (int k = 0; k < 2; ++k) dst[m][k] = *(const LAS bf16x8*)(lds + PG8_SA(b, h) + aoff + m * 2048 + k * 1024); } while (0)
#define PG8_LDB(dst, b, h) do { _Pragma("unroll") for (int n = 0; n < 2; ++n) _Pragma("unroll") for (int k = 0; k < 2; ++k) dst[n][k] = *(const LAS bf16x8*)(lds + PG8_SB(b, h) + boff + n * 2048 + k * 1024); } while (0)
#define PG8_MMA(ai, bj, At, Bt) do { __builtin_amdgcn_s_setprio(1); _Pragma("unroll") for (int m = 0; m < 4; ++m) _Pragma("unroll") for (int n = 0; n < 2; ++n) _Pragma("unroll") for (int k = 0; k < 2; ++k) \
        acc[ai][bj][m][n] = __builtin_amdgcn_mfma_f32_16x16x32_bf16(Bt[n][k], At[m][k], acc[ai][bj][m][n], 0, 0, 0); __builtin_amdgcn_s_setprio(0); } while (0)
#define PG8_WAIT_V(n) asm volatile("s_waitcnt vmcnt(" #n ")" ::: "memory")
#define PG8_WAIT_L(n) asm volatile("s_waitcnt lgkmcnt(" #n ")" ::: "memory")
#define PG8_BAR __builtin_amdgcn_s_barrier()
#define PG8_SCHED __builtin_amdgcn_sched_barrier(0)
#define PG8_ZERO() do { _Pragma("unroll") for (int a = 0; a < 2; ++a) _Pragma("unroll") for (int b = 0; b < 2; ++b) _Pragma("unroll") for (int m = 0; m < 4; ++m) _Pragma("unroll") for (int n = 0; n < 2; ++n) acc[a][b][m][n] = (f32x4){0.f, 0.f, 0.f, 0.f}; } while (0)
    Unit cur, nxt; int ui = 0;
    if (!S.next(0, cur)) return;
    f32x4 acc[2][2][4][2];
    PG8_ZERO();
    bf16x8 At[4][2], B0[2][2], B1[2][2];
    const char* cA = cur.a; const char* cB = cur.b;
    PG8_STAGE(PG8_SB(0, 0), cB, voffB); PG8_STAGE(PG8_SB(0, 1), cB + hstepB, voffB); PG8_STAGE(PG8_SA(0, 0), cA, voffA); PG8_STAGE(PG8_SA(0, 1), cA + hstepA, voffA);
    if (wr == 1) PG8_BAR;
    PG8_WAIT_V(2); PG8_BAR;
    PG8_STAGE(PG8_SB(1, 0), cB + kstep, voffB); PG8_STAGE(PG8_SA(1, 0), cA + kstep, voffA); PG8_STAGE(PG8_SB(1, 1), cB + hstepB + kstep, voffB);
    PG8_WAIT_V(6); PG8_BAR;
    for (;;) {
        const bool has_next = S.next(ui + 1, nxt);
        const char* nA = has_next ? nxt.a : cA; const char* nB = has_next ? nxt.b : cB;
#pragma nounroll
        for (int t = 0; t < nt; t += 2) {
            const bool last = (t == nt - 2);
            const char* a1 = cA + (size_t)(t + 1) * kstep;
            const char* a2 = last ? nA : cA + (size_t)(t + 2) * kstep; const char* b2 = last ? nB : cB + (size_t)(t + 2) * kstep;
            const char* a3 = a2 + kstep; const char* b3 = b2 + kstep;
            PG8_LDB(B0, 0, 0); PG8_LDB(B1, 0, 1); PG8_SCHED; PG8_LDA(At, 0, 0); PG8_STAGE(PG8_SA(1, 1), a1 + hstepA, voffA);
            PG8_WAIT_V(8); PG8_WAIT_L(0); PG8_BAR; PG8_MMA(0, 0, At, B0); PG8_MMA(0, 1, At, B1); PG8_BAR; PG8_SCHED;
            PG8_LDA(At, 0, 1); PG8_STAGE(PG8_SB(0, 0), b2, voffB); PG8_STAGE(PG8_SB(0, 1), b2 + hstepB, voffB); PG8_STAGE(PG8_SA(0, 0), a2, voffA);
            PG8_WAIT_V(8); PG8_WAIT_L(0); PG8_BAR; PG8_MMA(1, 0, At, B0); PG8_MMA(1, 1, At, B1); PG8_BAR; PG8_SCHED;
            PG8_LDB(B0, 1, 0); PG8_LDB(B1, 1, 1); PG8_SCHED; PG8_LDA(At, 1, 0); PG8_STAGE(PG8_SA(0, 1), a2 + hstepA, voffA);
            PG8_WAIT_V(8); PG8_WAIT_L(0); PG8_BAR; PG8_MMA(0, 0, At, B0); PG8_MMA(0, 1, At, B1); PG8_BAR; PG8_SCHED;
            PG8_LDA(At, 1, 1); PG8_STAGE(PG8_SB(1, 0), b3, voffB); PG8_STAGE(PG8_SB(1, 1), b3 + hstepB, voffB); PG8_STAGE(PG8_SA(1, 0), a3, voffA);
            PG8_WAIT_V(8); PG8_WAIT_L(0); PG8_BAR; PG8_MMA(1, 0, At, B0); PG8_MMA(1, 1, At, B1); PG8_BAR; PG8_SCHED;
        }
        if constexpr (ALIGN_EPI) { if (wr == 0) PG8_BAR; }
        if constexpr (!Epi::AFTER_DRAIN) { E(acc, cur, wr, wc, fr, fq); }
        if (!has_next) break;
        if (!(Epi::ACCUM2 && cur.sub == 0)) PG8_ZERO();
        cur = nxt; cA = nA; cB = nB; ++ui;
        if constexpr (ALIGN_EPI) { if (wr == 1) PG8_BAR; }
    }
    PG8_WAIT_V(0);
    if constexpr (!ALIGN_EPI) { if (wr == 0) PG8_BAR; }
    PG8_BAR;
    if constexpr (Epi::AFTER_DRAIN) { E.fused(acc, cur, wr, wc, fr, fq, lds); }
#undef PG8_SA
#undef PG8_SB
#undef PG8_STAGE
#undef PG8_LDA
#undef PG8_LDB
#undef PG8_MMA
#undef PG8_WAIT_V
#undef PG8_WAIT_L
#undef PG8_BAR
#undef PG8_SCHED
#undef PG8_ZERO
}
}

namespace att {
constexpr int D = 128, NW = 8, QBLK = 32, KVBLK = 64;
constexpr float SCALE = 0.088388347648318440f;
constexpr float THR = 8.f;
constexpr int LDQ = 2048, LDK = 512, LDO = 2048;
constexpr size_t SHM_V = KVBLK * D * 2, SHM_K = KVBLK * D * 2, SHM_ATTN = 2 * SHM_V + 2 * SHM_K + NW * 64 * 4;
#define KSWZ(row, colB) ((row) * 256 + ((colB) ^ (((row) & 7) << 4)))
#define SBAR() __builtin_amdgcn_sched_barrier(0)
__device__ __forceinline__ int crow(int r, int hi) { return (r & 3) + 8 * (r >> 2) + 4 * hi; }
__device__ __forceinline__ void partialSM(f32x16& p0, f32x16& p1, float& m_reg, float& mn, float& alpha) {
  constexpr float C = SCALE * 1.4426950408889634f;
  float pmax = p0[0]; for (int r = 1; r < 16; ++r) pmax = fmaxf(pmax, p0[r]); for (int r = 0; r < 16; ++r) pmax = fmaxf(pmax, p1[r]);
  { auto rr = __builtin_amdgcn_permlane32_swap(__float_as_uint(pmax), __float_as_uint(pmax), false, false);
    pmax = fmaxf(__uint_as_float(rr[0]), __uint_as_float(rr[1])); }
  if (__builtin_expect(__all(pmax - m_reg <= THR / SCALE), 1)) { mn = m_reg; alpha = 1.f; }
  else { mn = fmaxf(m_reg, pmax); alpha = __builtin_amdgcn_exp2f((m_reg - mn) * C); m_reg = mn; }
  float mnC = -mn * C;
  for (int r = 0; r < 16; ++r) p0[r] = fmaf(p0[r], C, mnC); for (int r = 0; r < 16; ++r) p1[r] = fmaf(p1[r], C, mnC);
  for (int r = 0; r < 16; ++r) p0[r] = __builtin_amdgcn_exp2f(p0[r]);
}
__device__ __forceinline__ void finishSM(f32x16& p0, f32x16& p1, float alpha, float& l_reg, bf16x8& pa0, bf16x8& pa1, bf16x8& pa2, bf16x8& pa3) {
  for (int r = 0; r < 16; ++r) p1[r] = __builtin_amdgcn_exp2f(p1[r]);
  float ps = 0; for (int r = 0; r < 16; ++r) ps += p0[r]; for (int r = 0; r < 16; ++r) ps += p1[r];
  { auto rr = __builtin_amdgcn_permlane32_swap(__float_as_uint(ps), __float_as_uint(ps), false, false);
    ps = __uint_as_float(rr[0]) + __uint_as_float(rr[1]); }
  l_reg = l_reg * alpha + ps;
#define PK4(P, BASE, OUT) do { unsigned a0 = cvt_pk_bf16(P[BASE + 0], P[BASE + 1]), a1 = cvt_pk_bf16(P[BASE + 2], P[BASE + 3]);   \
    unsigned b0 = cvt_pk_bf16(P[BASE + 4], P[BASE + 5]), b1 = cvt_pk_bf16(P[BASE + 6], P[BASE + 7]);                              \
    auto r0 = __builtin_amdgcn_permlane32_swap(a0, b0, false, false); auto r1 = __builtin_amdgcn_permlane32_swap(a1, b1, false, false); \
    u32x4 w = {r0[0], r1[0], r0[1], r1[1]}; OUT = *reinterpret_cast<bf16x8*>(&w); } while (0)
  PK4(p0, 0, pa0); PK4(p0, 8, pa1); PK4(p1, 0, pa2); PK4(p1, 8, pa3);
#undef PK4
}
__device__ __forceinline__ void qkt(f32x16& p0, f32x16& p1, const bf16_t* Ks, const bf16x8* qr, int r32, int hi) {
  p0 = f32x16{}; p1 = f32x16{};
  for (int d0 = 0; d0 < 8; ++d0) { int cb = (d0 * 16 + hi * 8) * 2;
    bf16x8 b0 = *reinterpret_cast<const bf16x8*>((const char*)Ks + KSWZ(r32, cb));
    bf16x8 b1 = *reinterpret_cast<const bf16x8*>((const char*)Ks + KSWZ(32 + r32, cb));
    p0 = __builtin_amdgcn_mfma_f32_32x32x16_bf16(b0, qr[d0], p0, 0, 0, 0);
    p1 = __builtin_amdgcn_mfma_f32_32x32x16_bf16(b1, qr[d0], p1, 0, 0, 0); }
}
__device__ __forceinline__ int v_st(int k, int c) { const int kk = (k & ~0xC) | ((k & 4) << 1) | ((k & 8) >> 1); return ((kk >> 3) * 4 + (c >> 5)) * 512 + ((kk & 7) * 32 + (c & 31)) * 2; }
__device__ __forceinline__ int v_rd_base(int lane) { return ((lane & 3) << 3) | (((lane >> 2) & 3) << 6) | (((lane >> 4) & 1) << 5) | (((lane >> 5) & 1) << 8); }
constexpr int v_rd_off(int d0, int ks, int half) { return d0 * 512 + ks * 4096 + half * 2048; }
template <int OFF> __device__ __forceinline__ s16x4 tr_read(int vb) {
  s16x4 r; asm volatile("ds_read_b64_tr_b16 %0, %1 offset:%2" : "=&v"(r) : "v"(vb), "i"(OFF) : "memory"); return r;
}
template <int D0> __device__ __forceinline__ void pv_one(f32x16& od, int vb, bf16x8 pa0, bf16x8 pa1, bf16x8 pa2, bf16x8 pa3) {
  const s16x4 l0 = tr_read<v_rd_off(D0, 0, 0)>(vb), h0 = tr_read<v_rd_off(D0, 0, 1)>(vb), l1 = tr_read<v_rd_off(D0, 1, 0)>(vb), h1 = tr_read<v_rd_off(D0, 1, 1)>(vb);
  const s16x4 l2 = tr_read<v_rd_off(D0, 2, 0)>(vb), h2 = tr_read<v_rd_off(D0, 2, 1)>(vb), l3 = tr_read<v_rd_off(D0, 3, 0)>(vb), h3 = tr_read<v_rd_off(D0, 3, 1)>(vb);
  asm volatile("s_waitcnt lgkmcnt(0)" ::: "memory"); SBAR();
#define PK(L, H) (bf16x8){L[0], L[1], L[2], L[3], H[0], H[1], H[2], H[3]}
  od = __builtin_amdgcn_mfma_f32_32x32x16_bf16(pa0, PK(l0, h0), od, 0, 0, 0);
  od = __builtin_amdgcn_mfma_f32_32x32x16_bf16(pa1, PK(l1, h1), od, 0, 0, 0);
  od = __builtin_amdgcn_mfma_f32_32x32x16_bf16(pa2, PK(l2, h2), od, 0, 0, 0);
  od = __builtin_amdgcn_mfma_f32_32x32x16_bf16(pa3, PK(l3, h3), od, 0, 0, 0);
#undef PK
}
__device__ __forceinline__ void pv_d0(f32x16* o, int vb, bf16x8 pa0, bf16x8 pa1, bf16x8 pa2, bf16x8 pa3) {
  pv_one<0>(o[0], vb, pa0, pa1, pa2, pa3); pv_one<1>(o[1], vb, pa0, pa1, pa2, pa3); pv_one<2>(o[2], vb, pa0, pa1, pa2, pa3); pv_one<3>(o[3], vb, pa0, pa1, pa2, pa3);
}
__device__ __forceinline__ const void* rfl64(const void* p) { const unsigned long long v = (unsigned long long)p; const unsigned lo = __builtin_amdgcn_readfirstlane((unsigned)v), hi = __builtin_amdgcn_readfirstlane((unsigned)(v >> 32)); return (const void*)(((unsigned long long)hi << 32) | lo); }
__device__ __forceinline__ void attn_dense_body(const bf16_t* Qb, const bf16_t* Kh, const bf16_t* Vh, bf16_t* Ob, int seq, char* lds, const int tid,
                                                const float* __restrict__ qg_, const float* __restrict__ ropeT_, const int tok0) {
  Qb = (const bf16_t*)rfl64(Qb); Kh = (const bf16_t*)rfl64(Kh); Vh = (const bf16_t*)rfl64(Vh); Ob = (bf16_t*)rfl64(Ob);
  const float* qg = (const float*)rfl64(qg_); const float* ropeT = (const float*)rfl64(ropeT_);
  int tid_ = tid; asm volatile("" : "+v"(tid_));
  const int wid = tid_ >> 6, lane = tid_ & 63, r32 = lane & 31, hi = lane >> 5;
  bf16_t* V_lds = (bf16_t*)lds; bf16_t* K_lds = (bf16_t*)(lds + 2 * SHM_V);
  float* ws = (float*)(lds + 2 * SHM_V + 2 * SHM_K) + wid * 64; float* li_l = ws; float* al_l = ws + 32;
  float m_reg = -1e30f, l_reg = 0; f32x16 o[4] = {}; bf16x8 qr[8];
  const unsigned qoff = (unsigned)((wid * QBLK + r32) * LDQ + hi * 8) * 2u;
#pragma unroll
  for (int d0 = 0; d0 < 8; ++d0) qr[d0] = *reinterpret_cast<const bf16x8*>((const char*)Qb + qoff + d0 * 32);
  {
    float ss = 0.f;
#pragma unroll
    for (int d0 = 0; d0 < 8; ++d0) { const u32x4 w = *reinterpret_cast<const u32x4*>(&qr[d0]);
#pragma unroll
      for (int e = 0; e < 4; ++e) { const float a = bf_lo(w[e]), b = bf_hi(w[e]); ss += a * a + b * b; } }
    ss += shx(ss, 32);
    const float rs = __builtin_amdgcn_rsqf(ss * (1.f / 128.f) + 1e-6f);
    const int trow = tok0 + wid * QBLK + r32;
#pragma unroll
    for (int hh = 0; hh < 2; ++hh) { const float* Tp = ropeT + (hh ? (trow & 63) : (trow >> 6)) * 64 + hi * 8;
#pragma unroll
      for (int dd = 0; dd < 2; ++dd) { const int d0 = hh * 4 + dd; const u32x4 w1 = *reinterpret_cast<const u32x4*>(&qr[d0]), w2 = *reinterpret_cast<const u32x4*>(&qr[d0 + 2]);
        const float* g1 = qg + d0 * 16 + hi * 8; const float* Tc = Tp + dd * 16; float o1[8], o2[8];
#pragma unroll
        for (int e = 0; e < 8; ++e) { const float x1 = ((e & 1) ? bf_hi(w1[e >> 1]) : bf_lo(w1[e >> 1])) * rs * g1[e], x2 = ((e & 1) ? bf_hi(w2[e >> 1]) : bf_lo(w2[e >> 1])) * rs * g1[32 + e];
          const float cs = Tc[e], sn = Tc[32 + e]; o1[e] = x1 * cs - x2 * sn; o2[e] = x2 * cs + x1 * sn; }
        u32x4 p1, p2;
#pragma unroll
        for (int e = 0; e < 4; ++e) { p1[e] = cvt_pk_bf16(o1[2 * e], o1[2 * e + 1]); p2[e] = cvt_pk_bf16(o2[2 * e], o2[2 * e + 1]); }
        qr[d0] = *reinterpret_cast<bf16x8*>(&p1); qr[d0 + 2] = *reinterpret_cast<bf16x8*>(&p2); } }
  }
  const int sr = tid_ >> 4, sc = (tid_ & 15) * 8, vst0 = v_st(sr, sc), vst1 = v_st(32 + sr, sc);
  const int vb0 = (int)(uintptr_t)V_lds + v_rd_base(lane);
  struct { bf16x8 vs0, vs1, ks0, ks1; } sr_[2];
  const unsigned kvoff = (unsigned)(sr * LDK + sc) * 2u;
#define SLOAD(i, k0) do { const unsigned o0_ = kvoff + (unsigned)(k0) * (LDK * 2), o1_ = o0_ + 32 * LDK * 2; \
    sr_[i].vs0 = *(const bf16x8*)((const char*)Vh + o0_); sr_[i].vs1 = *(const bf16x8*)((const char*)Vh + o1_); \
    sr_[i].ks0 = *(const bf16x8*)((const char*)Kh + o0_); sr_[i].ks1 = *(const bf16x8*)((const char*)Kh + o1_); } while (0)
#define SWRITE(b, i) do { *(bf16x8*)((char*)V_lds + (b) * SHM_V + vst0) = sr_[i].vs0;          \
    *(bf16x8*)((char*)V_lds + (b) * SHM_V + vst1) = sr_[i].vs1; int kc = sc * 2;               \
    *(bf16x8*)((char*)K_lds + (b) * SHM_K + KSWZ(sr, kc)) = sr_[i].ks0;                       \
    *(bf16x8*)((char*)K_lds + (b) * SHM_K + KSWZ(32 + sr, kc)) = sr_[i].ks1; } while (0)
#define SWAIT() asm volatile("s_waitcnt vmcnt(4)" ::: "memory")
#define RESC(a) do { if (__any((a) < 1.f)) { if (hi == 0) al_l[r32] = (a); asm volatile("s_waitcnt lgkmcnt(0)" ::: "memory"); \
    for (int d = 0; d < 4; ++d) for (int r = 0; r < 16; ++r) o[d][r] *= al_l[crow(r, hi)]; } } while (0)
  f32x16 pA0, pA1, pB0, pB1; float mnA, mnB, alA, alB; bf16x8 pa0, pa1, pa2, pa3; const int NT = seq / KVBLK;
  constexpr int SE = 0, SO = 1;
  SLOAD(SE, 0); asm volatile("s_waitcnt vmcnt(0)" ::: "memory"); SWRITE(0, SE); __syncthreads();
  qkt(pA0, pA1, K_lds, qr, r32, hi); partialSM(pA0, pA1, m_reg, mnA, alA);
  SLOAD(SO, KVBLK); if (2 < NT) SLOAD(SE, 2 * KVBLK);
  SWAIT(); SWRITE(1, SO); __syncthreads();
  for (int j = 1; j + 1 < NT; j += 2) {
    SBAR(); qkt(pB0, pB1, (bf16_t*)((char*)K_lds + SHM_K), qr, r32, hi);
    finishSM(pA0, pA1, alA, l_reg, pa0, pa1, pa2, pa3); SBAR();
    SLOAD(SO, (j + 2) * KVBLK); SBAR();
    pv_d0(o, vb0, pa0, pa1, pa2, pa3); partialSM(pB0, pB1, m_reg, mnB, alB);
    __syncthreads(); SWAIT(); SWRITE(0, SE);
    RESC(alB); __syncthreads();
    SBAR(); qkt(pA0, pA1, K_lds, qr, r32, hi);
    finishSM(pB0, pB1, alB, l_reg, pa0, pa1, pa2, pa3); SBAR();
    if (j + 3 < NT) SLOAD(SE, (j + 3) * KVBLK); SBAR();
    pv_d0(o, vb0 + (int)SHM_V, pa0, pa1, pa2, pa3); partialSM(pA0, pA1, m_reg, mnA, alA);
    __syncthreads(); SWAIT(); SWRITE(1, SO);
    RESC(alA); __syncthreads();
  }
  SBAR(); qkt(pB0, pB1, (bf16_t*)((char*)K_lds + SHM_K), qr, r32, hi);
  finishSM(pA0, pA1, alA, l_reg, pa0, pa1, pa2, pa3); SBAR();
  pv_d0(o, vb0, pa0, pa1, pa2, pa3); partialSM(pB0, pB1, m_reg, mnB, alB);
  __syncthreads(); RESC(alB);
  finishSM(pB0, pB1, alB, l_reg, pa0, pa1, pa2, pa3); SBAR();
  pv_d0(o, vb0 + (int)SHM_V, pa0, pa1, pa2, pa3);
  if (hi == 0) li_l[r32] = l_reg; asm volatile("s_waitcnt lgkmcnt(0)" ::: "memory");
  float rli[16];
#pragma unroll
  for (int r = 0; r < 16; ++r) rli[r] = __builtin_amdgcn_rcpf(li_l[crow(r, hi)]);
  const unsigned ooff = (unsigned)((wid * QBLK + 4 * hi) * LDO + r32) * 2u;
#pragma unroll
  for (int r = 0; r < 16; ++r) { const int orow = (r & 3) + 8 * (r >> 2);
    for (int d0 = 0; d0 < 4; ++d0) *(bf16_t*)((char*)Ob + ooff + (orow * LDO + d0 * 32) * 2) = (bf16_t)(cvt_pk_bf16(o[d0][r] * rli[r], 0.f) & 0xffffu); }
#undef SLOAD
#undef SWRITE
#undef SWAIT
#undef RESC
}
#undef SBAR
}


#define XB_TMO      128
#define XB_XCNT(j)  (256  + 64 * (j))
#define XB_XSUB(j)  (1280 + 64 * (j))
#define XB_XGEN(j)  (2304 + 64 * (j))
#define XB_TOP      3328
#define XB_TOPGEN   3392
#define XCD_BAR_WORDS 3456
#define XB_SPIN_CAP (1u << 23)
__device__ __forceinline__ unsigned xb_ld(unsigned* p)              { return __hip_atomic_load(p, __ATOMIC_RELAXED, __HIP_MEMORY_SCOPE_AGENT); }
__device__ __forceinline__ unsigned xb_add(unsigned* p, unsigned v) { return __hip_atomic_fetch_add(p, v, __ATOMIC_RELAXED, __HIP_MEMORY_SCOPE_AGENT); }
__device__ __forceinline__ unsigned xb_xcc_id() { return (unsigned)__builtin_amdgcn_s_getreg((3 << 11) | 20) & 0xFu; }
#define XB_SPIN(cond, bar) do { unsigned _sp = 0; while (cond) { __builtin_amdgcn_s_sleep(1); \
    if ((++_sp & 255u) == 0u) { if (xb_ld(&(bar)[XB_TMO])) break; if (_sp > XB_SPIN_CAP) { atomicAdd(&(bar)[XB_TMO], 1u); break; } } } } while (0)
__device__ __forceinline__ void xcd_barrier_complete(unsigned* bar, unsigned x, unsigned& nloc, unsigned& nx) {
    const unsigned G = gridDim.x * gridDim.y * gridDim.z;
    unsigned sum, cnt, mine, sp = 0u;
    for (;;) {
        sum = 0u; cnt = 0u; mine = 0u;
#pragma unroll
        for (unsigned j = 0; j < 16; ++j) { const unsigned c = xb_ld(&bar[XB_XCNT(j)]); sum += c; cnt += (c > 0u) ? 1u : 0u; mine = (j == x) ? c : mine; }
        if (sum == G) break;
        __builtin_amdgcn_s_sleep(1);
        if ((++sp & 255u) == 0u) { if (xb_ld(&bar[XB_TMO])) break; if (sp > XB_SPIN_CAP) { atomicAdd(&bar[XB_TMO], 1u); break; } }
    }
    nloc = mine > 0u ? mine : 1u; nx = cnt > 0u ? cnt : 1u;
}
__device__ __forceinline__ void xcd_barrier(unsigned* bar, volatile LAS unsigned* st) {
    asm volatile("s_waitcnt vmcnt(0)" ::: "memory");
    __syncthreads();
    if (threadIdx.x == 0) {
        const unsigned x = xb_xcc_id();
        __builtin_amdgcn_s_waitcnt(0);
        unsigned nloc = st[0], nx = st[1];
        if (nloc == 0u) { xcd_barrier_complete(bar, x, nloc, nx); st[0] = nloc; st[1] = nx; }
        const unsigned old = xb_add(&bar[XB_XSUB(x)], 1u);
        const unsigned gen = old / nloc;
        if (old + 1u == (gen + 1u) * nloc) {
            __builtin_amdgcn_fence(__ATOMIC_RELEASE, "agent");
            asm volatile("s_waitcnt vmcnt(0)" ::: "memory");
            const unsigned og = xb_add(&bar[XB_TOP], 1u);
            const unsigned tg = og / nx;
            if (og + 1u == (tg + 1u) * nx) xb_add(&bar[XB_TOPGEN], 1u);
            else XB_SPIN(xb_ld(&bar[XB_TOPGEN]) == tg, bar);
            __builtin_amdgcn_fence(__ATOMIC_ACQUIRE, "agent");
            xb_add(&bar[XB_XGEN(x)], 1u);
            asm volatile("s_waitcnt vmcnt(0)" ::: "memory");
        } else {
            XB_SPIN(xb_ld(&bar[XB_XGEN(x)]) == gen, bar);
            __builtin_amdgcn_fence(__ATOMIC_ACQUIRE, "agent");
            asm volatile("s_waitcnt vmcnt(0)" ::: "memory");
        }
    }
    __syncthreads();
}
struct Args { const float* in[25]; float* out; unsigned char* ws; int ph_lo, ph_hi; };
typedef const __attribute__((address_space(4))) Args* KArgs;
enum { IN_X = 0, IN_MEM, IN_MIXG, IN_WIN, IN_QG, IN_KG, IN_CONVW, IN_CONVB, IN_LWR, IN_LBR, IN_LWI, IN_LBI, IN_LAM, IN_WA, IN_WR, IN_WMIX, IN_CROSSG, IN_MEMG,
       IN_WXQ, IN_WXKV, IN_WXO, IN_MLPG, IN_WUP, IN_WDOWN, IN_FING };

__device__ __forceinline__ void cvt_tile(const float* __restrict__ W, int N, bf16_t* __restrict__ WT, int ldk, const float* __restrict__ gain, float sc, LAS float* scr, int item, int lane) {
    const int nblk = N >> 6, kb = item / nblk, nb = item - kb * nblk, k0 = kb * 64, n0 = nb * 64;
    const int l16 = lane & 15, l4 = lane >> 4;
#pragma unroll 4
    for (int i = 0; i < 16; ++i) { const int kk = 4 * i + l4; f32x4 v = *(const f32x4*)(W + (size_t)(k0 + kk) * N + n0 + 4 * l16);
        const float g = gain ? gain[k0 + kk] * sc : sc; v = v * g;
        LAS float* d = scr + kk * 65 + 4 * l16; d[0] = v[0]; d[1] = v[1]; d[2] = v[2]; d[3] = v[3]; }
    LDS_WAIT(); asm volatile("" ::: "memory");
    const int c = lane & 7;
#pragma unroll
    for (int j = 0; j < 8; ++j) { const int n = (lane >> 3) + 8 * j; const LAS float* s = scr + (8 * c) * 65 + n;
        u32x4 o; o.x = cvt_pk_bf16(s[0 * 65], s[1 * 65]); o.y = cvt_pk_bf16(s[2 * 65], s[3 * 65]); o.z = cvt_pk_bf16(s[4 * 65], s[5 * 65]); o.w = cvt_pk_bf16(s[6 * 65], s[7 * 65]);
        *(u32x4*)(WT + (size_t)(n0 + n) * ldk + k0 + 8 * c) = o; }
    LDS_WAIT(); asm volatile("" ::: "memory");
}

__device__ __forceinline__ float gelu_tanh(float y) { const float z = 0.7978845608028654f * (y + 0.044715f * y * y * y); return y * fast_sigmoid(2.0f * z); }

__device__ __forceinline__ void lru_sweep_item(LAS unsigned char* lds, KArgs args, int l, int item, int tid, int lane, int w, bf16_t* Yout) {
    unsigned char* ws = args->ws;
    const int b = item >> 6, n = (item >> 2) & 15, dq = item & 3;
    LAS unsigned char* UFB = lds;
    LAS float* UF32 = (LAS float*)(lds + 32768);
    LAS float* Z = (LAS float*)(lds + 49152);
    LAS float* SEG = (LAS float*)(lds + 81920);
    LAS float* CAR = (LAS float*)(lds + 86016);
    const size_t rowbase = (size_t)b * SEQ;
    const bf16_t* U = (const bf16_t*)(ws + WS_U);
    const bf16_t* Y = (const bf16_t*)(ws + WS_Y);
    float* HF = (float*)(ws + WS_HF);
    const int cgp = tid & 15, tq = tid >> 4, cch = n * 128 + cgp * 8;
    f32x4 cw0[4], cw1[4], cb0, cb1;
    { const float* cw = args->in[IN_CONVW] + (size_t)l * 4 * DM + cch; const float* cb = args->in[IN_CONVB] + (size_t)l * DM + cch;
#pragma unroll
      for (int t = 0; t < 4; ++t) { cw0[t] = *(const f32x4*)(cw + t * DM); cw1[t] = *(const f32x4*)(cw + t * DM + 4); }
      cb0 = *(const f32x4*)cb; cb1 = *(const f32x4*)(cb + 4); }
    const bool own32 = (cgp >> 2) == dq;
    const int ech = tid & 31, tg = tid >> 5, chg = n * 128 + dq * 32 + ech;
    const int rt = w & 3, mat = w >> 2, r32 = lane & 31, hi = lane >> 5;
    const bf16_t* LW = (const bf16_t*)(ws + WS_W + W_LRU);
    for (int dir = 0; dir < 2; ++dir) {
        bf16x8 bfr[8];
        { const bf16_t* wp = LW + ((size_t)((mat * 2 + dir) * 16 + n) * 128 + dq * 32 + r32) * 128 + hi * 8;
#pragma unroll
          for (int ks = 0; ks < 8; ++ks) bfr[ks] = *(const bf16x8*)(wp + ks * 16); }
        const float brv = args->in[IN_LBR][(size_t)(l * 2 + dir) * DM + chg] * -1.4426950408889634f, biv = args->in[IN_LBI][(size_t)(l * 2 + dir) * DM + chg] * -1.4426950408889634f;
        const float lam = args->in[IN_LAM][(size_t)(l * 2 + dir) * DM + chg];
        const float sp = softplus_neg(lam);
        const float c1 = -8.0f * sp * 1.4426950408889634f, c2 = -16.0f * sp;
        const bool small = __all(16.0f * sp < 0.3f);
        if (tid < 64) CAR[tid] = 0.f;
        u32x4 ur[7];
#define LRU_LOADROWS(cc) do { _Pragma("unroll") for (int j = 0; j < 7; ++j) { const int t = (cc) * 128 + 4 * tq - 2 + j; \
            ur[j] = (t >= 0 && t < SEQ) ? *(const u32x4*)(U + (rowbase + t) * DM + cch) : (u32x4){0u, 0u, 0u, 0u}; } } while (0)
        LRU_LOADROWS(dir ? 31 : 0);
        for (int k = 0; k < 32; ++k) {
            const int c = dir ? 31 - k : k, t0 = c * 128;
            {
                f32x4 o0[4], o1[4];
#pragma unroll
                for (int i = 0; i < 4; ++i) { o0[i] = cb0; o1[i] = cb1; }
#pragma unroll
                for (int j = 0; j < 7; ++j) { const u32x4 q = ur[j]; const f32x4 r0 = {bf_lo(q.x), bf_hi(q.x), bf_lo(q.y), bf_hi(q.y)}, r1 = {bf_lo(q.z), bf_hi(q.z), bf_lo(q.w), bf_hi(q.w)};
#pragma unroll
                    for (int i = 0; i < 4; ++i) { const int tap = j - i; if (tap >= 0 && tap < 4) { o0[i] += r0 * cw0[tap]; o1[i] += r1 * cw1[tap]; } } }
#pragma unroll
                for (int i = 0; i < 4; ++i) { const int row = 4 * tq + i; u32x4 pk; pk.x = cvt_pk_bf16(o0[i][0], o0[i][1]); pk.y = cvt_pk_bf16(o0[i][2], o0[i][3]); pk.z = cvt_pk_bf16(o1[i][0], o1[i][1]); pk.w = cvt_pk_bf16(o1[i][2], o1[i][3]);
                    *(LAS u32x4*)(UFB + row * 256 + ((cgp * 16) ^ ((row & 7) << 4))) = pk;
                    if (own32) { LAS float* d = UF32 + row * 32 + (cgp & 3) * 8; *(LAS f32x4*)d = o0[i]; *(LAS f32x4*)(d + 4) = o1[i]; } }
            }
            if (k + 1 < 32) LRU_LOADROWS(dir ? 30 - k : k + 1);
            __syncthreads();
            {
                f32x16 acc = {};
#pragma unroll
                for (int ks = 0; ks < 8; ++ks) { const int row = rt * 32 + r32; const bf16x8 a = *(const LAS bf16x8*)(UFB + row * 256 + (((ks * 16 + hi * 8) * 2) ^ ((row & 7) << 4)));
                    acc = __builtin_amdgcn_mfma_f32_32x32x16_bf16(a, bfr[ks], acc, 0, 0, 0); }
#pragma unroll
                for (int r = 0; r < 16; ++r) Z[(mat * 128 + rt * 32 + att::crow(r, hi)) * 32 + r32] = acc[r];
            }
            __syncthreads();
            float av[8], bv[8], hfv[8], yv[8];
            if (dir) {
#pragma unroll
                for (int j = 0; j < 8; ++j) { const int tok = 127 - (tg * 8 + j); const size_t gi = (rowbase + t0 + tok) * DM + chg; hfv[j] = HF[gi]; yv[j] = bf1(Y[gi]); } }
            float Ap = 1.f, Hh = 0.f;
#pragma unroll
            for (int j = 0; j < 8; ++j) { const int p = tg * 8 + j, tok = dir ? 127 - p : p;
                const float zr = Z[tok * 32 + ech], zi = Z[(128 + tok) * 32 + ech], uf = UF32[tok * 32 + ech];
                const float er = __builtin_amdgcn_exp2f(fmaf(zr, -1.4426950408889634f, brv)), ei = __builtin_amdgcn_exp2f(fmaf(zi, -1.4426950408889634f, biv));
                const float rg = __builtin_amdgcn_rcpf(1.0f + er), ig = __builtin_amdgcn_rcpf(1.0f + ei);
                const float a = __builtin_amdgcn_exp2f(c1 * rg), x2 = c2 * rg;
                float oma2 = -x2 * (1.0f + x2 * (0.5f + x2 * (0.16666667f + x2 * (0.041666668f + x2 * (0.0083333338f + x2 * 0.0013888889f)))));
                if (!small) oma2 = (x2 > -0.3f) ? oma2 : (1.0f - a * a);
                const float bt = __builtin_amdgcn_sqrtf(oma2) * ig * uf;
                av[j] = a; bv[j] = bt; Hh = a * Hh + bt; Ap *= a; }
            SEG[(tg * 32 + ech) * 2] = Ap; SEG[(tg * 32 + ech) * 2 + 1] = Hh;
            __syncthreads();
            {
                float h = CAR[(k & 1) * 32 + ech];
#pragma unroll
                for (int s = 0; s < 15; ++s) { const f32x2 sg = *(const LAS f32x2*)(SEG + (s * 32 + ech) * 2); h = (s < tg) ? sg.x * h + sg.y : h; }
#pragma unroll
                for (int j = 0; j < 8; ++j) { const int p = tg * 8 + j, tok = dir ? 127 - p : p; const size_t gi = (rowbase + t0 + tok) * DM + chg; h = av[j] * h + bv[j];
                    if (dir == 0) HF[gi] = h;
                    else { const float o = (h + hfv[j]) * gelu_tanh(yv[j]); Yout[gi] = (bf16_t)(cvt_pk_bf16(o, 0.f) & 0xffffu); } }
                if (tg == 15) CAR[((k + 1) & 1) * 32 + ech] = h;
            }
        }
#undef LRU_LOADROWS
        asm volatile("s_waitcnt vmcnt(0)" ::: "memory"); __syncthreads();
        __builtin_amdgcn_fence(__ATOMIC_ACQUIRE, "agent");
    }
}
__device__ __forceinline__ void lru_sweep2_item(LAS unsigned char* lds, KArgs args, int l, int item, int tid, int lane, int w, bf16_t* Yout) {
    unsigned char* ws = args->ws;
    const int b = item >> 6, n = (item >> 2) & 15, dq = item & 3;
    LAS unsigned char* UFB = lds;
    LAS float* Z = (LAS float*)(lds + 65536);
    LAS float* SEG = (LAS float*)(lds + 131072);
    LAS float* CAR = (LAS float*)(lds + 139264);
    LAS float* CW = (LAS float*)(lds + 139776);
    const size_t rowbase = (size_t)b * SEQ;
    const bf16_t* U = (const bf16_t*)(ws + WS_U);
    const bf16_t* Y = (const bf16_t*)(ws + WS_Y);
    float* HS = (float*)(ws + WS_HF);
    const int rt = w & 3, mat = w >> 2;
    const int tq = tid >> 4, cch = n * 128 + (tid & 15) * 8, chg = n * 128 + dq * 32 + (tid & 31);
    for (int i = tid; i < 640; i += 512) CW[i] = (i < 512) ? args->in[IN_CONVW][(size_t)l * 4 * DM + (size_t)(i >> 7) * DM + n * 128 + (i & 127)] : args->in[IN_CONVB][(size_t)l * DM + n * 128 + (i & 127)];
    if (tid < 128) CAR[tid] = 0.f;
    const bf16_t* LW = (const bf16_t*)(ws + WS_W + W_LRU);
    float brv[2], biv[2], c1[2], c2[2]; bool small = true;
#pragma unroll
    for (int dir = 0; dir < 2; ++dir) { brv[dir] = args->in[IN_LBR][(size_t)(l * 2 + dir) * DM + chg] * -1.4426950408889634f; biv[dir] = args->in[IN_LBI][(size_t)(l * 2 + dir) * DM + chg] * -1.4426950408889634f;
        const float lam = args->in[IN_LAM][(size_t)(l * 2 + dir) * DM + chg]; const float sp = softplus_neg(lam);
        c1[dir] = -8.0f * sp * 1.4426950408889634f; c2[dir] = -16.0f * sp; small = small && (16.0f * sp < 0.3f); }
    small = __all(small);
    u32x4 ur[2][7];
#define LRU_LOADROWS(d, cc) do { int tb_ = (cc) * 128 + 4 * tq - 2; asm volatile("" : "+v"(tb_));     \
        const unsigned ob_ = (unsigned)(((int)rowbase + tb_) * DM + cch) * 2u; \
        _Pragma("unroll") for (int j = 0; j < 7; ++j) { const bool ok_ = (unsigned)(tb_ + j) < (unsigned)SEQ; \
            ur[d][j] = ok_ ? *(const u32x4*)((const char*)U + (ob_ + (unsigned)j * (unsigned)(DM * 2))) : (u32x4){0u, 0u, 0u, 0u}; } } while (0)
    LRU_LOADROWS(0, 0); LRU_LOADROWS(1, 31);
    __syncthreads();
    for (int k = 0; k < 32; ++k) {
        const bool fin = k >= 16;
        const int t_ = w * 64 + CUR_LANE();
        const int cgp = t_ & 15, tq = t_ >> 4, cch = n * 128 + cgp * 8, ech = t_ & 31, tg = t_ >> 5, chg = n * 128 + dq * 32 + ech, ecol = dq * 32 + ech, r32 = t_ & 31, hi = (t_ >> 5) & 1;
        bf16x8 bfr[2][8];
#pragma unroll
        for (int dir = 0; dir < 2; ++dir) { const bf16_t* wp = LW + ((size_t)((mat * 2 + dir) * 16 + n) * 128 + dq * 32 + r32) * 128 + hi * 8;
#pragma unroll
            for (int ks = 0; ks < 8; ++ks) bfr[dir][ks] = *(const bf16x8*)(wp + ks * 16); }
        {
            f32x4 cw0[4], cw1[4];
#pragma unroll
            for (int t = 0; t < 4; ++t) { cw0[t] = *(const LAS f32x4*)(CW + t * 128 + cgp * 8); cw1[t] = *(const LAS f32x4*)(CW + t * 128 + cgp * 8 + 4); }
            const f32x4 cb0 = *(const LAS f32x4*)(CW + 512 + cgp * 8), cb1 = *(const LAS f32x4*)(CW + 512 + cgp * 8 + 4);
#pragma unroll
            for (int dir = 0; dir < 2; ++dir) {
                f32x4 o0[4], o1[4];
#pragma unroll
                for (int i = 0; i < 4; ++i) { o0[i] = cb0; o1[i] = cb1; }
#pragma unroll
                for (int j = 0; j < 7; ++j) { const u32x4 q = ur[dir][j]; const f32x4 r0 = {bf_lo(q.x), bf_hi(q.x), bf_lo(q.y), bf_hi(q.y)}, r1 = {bf_lo(q.z), bf_hi(q.z), bf_lo(q.w), bf_hi(q.w)};
#pragma unroll
                    for (int i = 0; i < 4; ++i) { const int tap = j - i; if (tap >= 0 && tap < 4) { o0[i] += r0 * cw0[tap]; o1[i] += r1 * cw1[tap]; } } }
#pragma unroll
                for (int i = 0; i < 4; ++i) { const int row = 4 * tq + i; u32x4 pk; pk.x = cvt_pk_bf16(o0[i][0], o0[i][1]); pk.y = cvt_pk_bf16(o0[i][2], o0[i][3]); pk.z = cvt_pk_bf16(o1[i][0], o1[i][1]); pk.w = cvt_pk_bf16(o1[i][2], o1[i][3]);
                    *(LAS u32x4*)(UFB + dir * 32768 + row * 256 + ((cgp * 16) ^ ((row & 7) << 4))) = pk; }
            }
        }
        if (k >= 15) asm volatile("s_waitcnt vmcnt(0)" ::: "memory");
        if (k + 1 < 32) { LRU_LOADROWS(0, k + 1); LRU_LOADROWS(1, 30 - k); }
        __syncthreads();
#pragma unroll
        for (int dir = 0; dir < 2; ++dir) {
            f32x16 acc = {};
#pragma unroll
            for (int ks = 0; ks < 8; ++ks) { const int row = rt * 32 + r32; const bf16x8 a = *(const LAS bf16x8*)(UFB + dir * 32768 + row * 256 + (((ks * 16 + hi * 8) * 2) ^ ((row & 7) << 4)));
                acc = __builtin_amdgcn_mfma_f32_32x32x16_bf16(a, bfr[dir][ks], acc, 0, 0, 0); }
#pragma unroll
            for (int r = 0; r < 16; ++r) Z[((dir * 2 + mat) * 128 + rt * 32 + att::crow(r, hi)) * 32 + r32] = acc[r];
        }
        __syncthreads();
        float av[2][8], bv[2][8], hsv[2][8], yv[2][8];
        if (fin) {
#pragma unroll
            for (int dir = 0; dir < 2; ++dir) { const int t0 = (dir ? 31 - k : k) * 128;
                unsigned oh = (unsigned)(((rowbase + t0 + (dir ? 127 - tg * 8 : tg * 8)) * DM + chg) * 4);
#pragma unroll
                for (int j = 0; j < 8; ++j) { hsv[dir][j] = *(const float*)((const char*)HS + oh); yv[dir][j] = bf1(*(const bf16_t*)((const char*)Y + (oh >> 1))); oh += dir ? (unsigned)(-DM * 4) : (unsigned)(DM * 4); asm volatile("" : "+v"(oh)); } } }
#pragma unroll
        for (int dir = 0; dir < 2; ++dir) { float Ap = 1.f, Hh = 0.f;
#pragma unroll
            for (int j = 0; j < 8; ++j) { const int p = tg * 8 + j, tok = dir ? 127 - p : p;
                const float zr = Z[((dir * 2 + 0) * 128 + tok) * 32 + ech], zi = Z[((dir * 2 + 1) * 128 + tok) * 32 + ech];
                const float uf = bf1(*(const LAS bf16_t*)(UFB + dir * 32768 + tok * 256 + ((((ecol >> 3) << 4) ^ ((tok & 7) << 4)) + (ecol & 7) * 2)));
                const float er = __builtin_amdgcn_exp2f(fmaf(zr, -1.4426950408889634f, brv[dir])), ei = __builtin_amdgcn_exp2f(fmaf(zi, -1.4426950408889634f, biv[dir]));
                const float rg = __builtin_amdgcn_rcpf(1.0f + er), ig = __builtin_amdgcn_rcpf(1.0f + ei);
                const float a = __builtin_amdgcn_exp2f(c1[dir] * rg), x2 = c2[dir] * rg;
                float oma2 = -x2 * (1.0f + x2 * (0.5f + x2 * (0.16666667f + x2 * (0.041666668f + x2 * (0.0083333338f + x2 * 0.0013888889f)))));
                if (!small) oma2 = (x2 > -0.3f) ? oma2 : (1.0f - a * a);
                const float bt = __builtin_amdgcn_sqrtf(oma2) * ig * uf;
                av[dir][j] = a; bv[dir][j] = bt; Hh = a * Hh + bt; Ap *= a; }
            *(LAS f32x2*)(SEG + ((dir * 16 + tg) * 32 + ech) * 2) = (f32x2){Ap, Hh}; }
        __syncthreads();
#pragma unroll
        for (int dir = 0; dir < 2; ++dir) {
            const int t0 = (dir ? 31 - k : k) * 128;
            float h = CAR[(dir * 2 + (k & 1)) * 32 + ech];
            f32x2 sgv[15];
#pragma unroll
            for (int s = 0; s < 15; ++s) sgv[s] = *(const LAS f32x2*)(SEG + ((dir * 16 + s) * 32 + ech) * 2);
            asm volatile("s_waitcnt lgkmcnt(0)" ::: "memory"); __builtin_amdgcn_sched_barrier(0);
#pragma unroll
            for (int s = 0; s < 15; ++s) { const float ae = (s < tg) ? sgv[s].x : 1.0f, he = (s < tg) ? sgv[s].y : 0.0f; h = fmaf(ae, h, he); }
            unsigned oh = (unsigned)(((rowbase + t0 + (dir ? 127 - tg * 8 : tg * 8)) * DM + chg) * 4);
#pragma unroll
            for (int j = 0; j < 8; ++j) { h = av[dir][j] * h + bv[dir][j];
                if (!fin) *(float*)((char*)HS + oh) = h;
                else { const float o = (h + hsv[dir][j]) * gelu_tanh(yv[dir][j]); *(bf16_t*)((char*)Yout + (oh >> 1)) = (bf16_t)(cvt_pk_bf16(o, 0.f) & 0xffffu); }
                oh += dir ? (unsigned)(-DM * 4) : (unsigned)(DM * 4); asm volatile("" : "+v"(oh)); }
            if (tg == 15) CAR[(dir * 2 + ((k + 1) & 1)) * 32 + ech] = h;
        }
    }
#undef LRU_LOADROWS
    asm volatile("s_waitcnt vmcnt(0)" ::: "memory"); __syncthreads();
}
__device__ __forceinline__ void lru_sweep3_item(LAS unsigned char* lds, KArgs args, int l, int item, int tid, int abl, int w, bf16_t* Yout) {
    unsigned char* ws = args->ws;
    const int b = item >> 6, n = (item >> 2) & 15, dq = item & 3;
    LAS unsigned char* UFB = lds;
    LAS float* Z = (LAS float*)(lds + 65536);
    LAS float* SEG = (LAS float*)(lds + 131072);
    LAS float* CAR = (LAS float*)(lds + 139264);
    LAS float* CW = (LAS float*)(lds + 139776);
    const size_t rowbase = (size_t)b * SEQ;
    const bf16_t* U = (const bf16_t*)(ws + WS_U);
    const bf16_t* Y = (const bf16_t*)(ws + WS_Y);
    float* HS = (float*)(ws + WS_HF);
    const int rt = w & 3, mat = w >> 2;
    const int chg = n * 128 + dq * 32 + (tid & 31);
    if (tid < 128) CAR[tid] = 0.f;
    const bf16_t* LW = (const bf16_t*)(ws + WS_W + W_LRU);
    float brv[2], biv[2], c1[2], c2[2]; bool small = true;
#pragma unroll
    for (int dir = 0; dir < 2; ++dir) { brv[dir] = args->in[IN_LBR][(size_t)(l * 2 + dir) * DM + chg] * -1.4426950408889634f; biv[dir] = args->in[IN_LBI][(size_t)(l * 2 + dir) * DM + chg] * -1.4426950408889634f;
        const float lam = args->in[IN_LAM][(size_t)(l * 2 + dir) * DM + chg]; const float sp = softplus_neg(lam);
        c1[dir] = -8.0f * sp * 1.4426950408889634f; c2[dir] = -16.0f * sp; small = small && (16.0f * sp < 0.3f); }
    small = __all(small);
    const bf16_t* UFG = (const bf16_t*)(ws + WS_UF);
#define LRU_DMA(kk) do { _Pragma("unroll") for (int dir_ = 0; dir_ < 2; ++dir_) { const int c0_ = (dir_ ? 31 - (kk) : (kk)) * 128; \
        _Pragma("unroll") for (int i_ = 0; i_ < 4; ++i_) { const int ln_ = CUR_LANE(), row_ = (i_ * 8 + w) * 4 + (ln_ >> 4), cs_ = (ln_ & 15) ^ (row_ & 7); \
            __builtin_amdgcn_global_load_lds((const unsigned*)(UFG + (rowbase + c0_ + row_) * DM + n * 128 + cs_ * 8), (LAS unsigned*)(UFB + dir_ * 32768 + (i_ * 8 + w) * 1024), 16, 0, 0); } } } while (0)
    bf16x8 bfr[2][8];
#define LRU_LOADW() do { const int ln_ = CUR_LANE(); _Pragma("unroll") for (int dir_ = 0; dir_ < 2; ++dir_) { const bf16_t* wp_ = LW + ((size_t)((mat * 2 + dir_) * 16 + n) * 128 + dq * 32 + (ln_ & 31)) * 128 + (ln_ >> 5) * 8; \
        _Pragma("unroll") for (int ks_ = 0; ks_ < 8; ++ks_) bfr[dir_][ks_] = *(const bf16x8*)(wp_ + ks_ * 16); } } while (0)
    LRU_LOADW();
    LRU_DMA(0);
    asm volatile("s_waitcnt vmcnt(0)" ::: "memory");
    __syncthreads();
    for (int k = 0; k < 32; ++k) {
        const bool fin = k >= 16;
        const int t_ = w * 64 + CUR_LANE();
        const int ech = t_ & 31, tg = t_ >> 5, chg = n * 128 + dq * 32 + ech, ecol = dq * 32 + ech, r32 = t_ & 31, hi = (t_ >> 5) & 1;
        if (k > 0) { asm volatile("s_waitcnt vmcnt(0)" ::: "memory"); __syncthreads(); }
        if (!(abl & 1))
#pragma unroll
        for (int dir = 0; dir < 2; ++dir) {
            f32x16 acc = {};
#pragma unroll
            for (int ks = 0; ks < 8; ++ks) { const int row = rt * 32 + r32; const bf16x8 a = *(const LAS bf16x8*)(UFB + dir * 32768 + row * 256 + (((ks * 16 + hi * 8) * 2) ^ ((row & 7) << 4)));
                acc = __builtin_amdgcn_mfma_f32_32x32x16_bf16(a, bfr[dir][ks], acc, 0, 0, 0); }
#pragma unroll
            for (int r = 0; r < 16; ++r) Z[((dir * 2 + mat) * 128 + rt * 32 + att::crow(r, hi)) * 32 + r32] = acc[r];
        }
        float ufv[2][8];
#pragma unroll
        for (int dir = 0; dir < 2; ++dir)
#pragma unroll
            for (int j = 0; j < 8; ++j) { const int p = tg * 8 + j, tok = dir ? 127 - p : p; ufv[dir][j] = bf1(*(const LAS bf16_t*)(UFB + dir * 32768 + tok * 256 + ((((ecol >> 3) << 4) ^ ((tok & 7) << 4)) + (ecol & 7) * 2))); }
        asm volatile("s_waitcnt lgkmcnt(0)" ::: "memory");
        __syncthreads();
        if (k + 1 < 32) LRU_DMA(k + 1);
        float av[2][8], bv[2][8], hsv[2][8], yv[2][8];
        if (fin && !(abl & 8)) {
#pragma unroll
            for (int dir = 0; dir < 2; ++dir) { const int t0 = (dir ? 31 - k : k) * 128;
                unsigned oh = (unsigned)(((rowbase + t0 + (dir ? 127 - tg * 8 : tg * 8)) * DM + chg) * 4);
#pragma unroll
                for (int j = 0; j < 8; ++j) { hsv[dir][j] = *(const float*)((const char*)HS + oh); yv[dir][j] = bf1(*(const bf16_t*)((const char*)Y + (oh >> 1))); oh += dir ? (unsigned)(-DM * 4) : (unsigned)(DM * 4); asm volatile("" : "+v"(oh)); } } }
        if (abl & 2) {
#pragma unroll
            for (int dir = 0; dir < 2; ++dir)
#pragma unroll
                for (int j = 0; j < 8; ++j) { av[dir][j] = 1.f; bv[dir][j] = ufv[dir][j]; }
        } else
#pragma unroll
        for (int dir = 0; dir < 2; ++dir) { float Ap = 1.f, Hh = 0.f;
#pragma unroll
            for (int j = 0; j < 8; ++j) { const int p = tg * 8 + j, tok = dir ? 127 - p : p;
                const float zr = Z[((dir * 2 + 0) * 128 + tok) * 32 + ech], zi = Z[((dir * 2 + 1) * 128 + tok) * 32 + ech];
                const float uf = ufv[dir][j];
                const float er = __builtin_amdgcn_exp2f(fmaf(zr, -1.4426950408889634f, brv[dir])), ei = __builtin_amdgcn_exp2f(fmaf(zi, -1.4426950408889634f, biv[dir]));
                const float rg = __builtin_amdgcn_rcpf(1.0f + er), ig = __builtin_amdgcn_rcpf(1.0f + ei);
                const float a = __builtin_amdgcn_exp2f(c1[dir] * rg), x2 = c2[dir] * rg;
                float oma2 = -x2 * (1.0f + x2 * (0.5f + x2 * (0.16666667f + x2 * (0.041666668f + x2 * (0.0083333338f + x2 * 0.0013888889f)))));
                if (!small) oma2 = (x2 > -0.3f) ? oma2 : (1.0f - a * a);
                const float bt = __builtin_amdgcn_sqrtf(oma2) * ig * uf;
                av[dir][j] = a; bv[dir][j] = bt; Hh = a * Hh + bt; Ap *= a; }
            *(LAS f32x2*)(SEG + ((dir * 16 + tg) * 32 + ech) * 2) = (f32x2){Ap, Hh}; }
        __syncthreads();
        if (!(abl & 4))
#pragma unroll
        for (int dir = 0; dir < 2; ++dir) {
            const int t0 = (dir ? 31 - k : k) * 128;
            float h = CAR[(dir * 2 + (k & 1)) * 32 + ech];
            f32x2 sgv[15];
#pragma unroll
            for (int s = 0; s < 15; ++s) sgv[s] = *(const LAS f32x2*)(SEG + ((dir * 16 + s) * 32 + ech) * 2);
            asm volatile("s_waitcnt lgkmcnt(0)" ::: "memory"); __builtin_amdgcn_sched_barrier(0);
#pragma unroll
            for (int s = 0; s < 15; ++s) { const float ae = (s < tg) ? sgv[s].x : 1.0f, he = (s < tg) ? sgv[s].y : 0.0f; h = fmaf(ae, h, he); }
            unsigned oh = (unsigned)(((rowbase + t0 + (dir ? 127 - tg * 8 : tg * 8)) * DM + chg) * 4);
#pragma unroll
            for (int j = 0; j < 8; ++j) { h = av[dir][j] * h + bv[dir][j];
                if (!fin) *(float*)((char*)HS + oh) = h;
                else { const float o = (h + hsv[dir][j]) * gelu_tanh(yv[dir][j]); *(bf16_t*)((char*)Yout + (oh >> 1)) = (bf16_t)(cvt_pk_bf16(o, 0.f) & 0xffffu); }
                oh += dir ? (unsigned)(-DM * 4) : (unsigned)(DM * 4); asm volatile("" : "+v"(oh)); }
            if (tg == 15) CAR[(dir * 2 + ((k + 1) & 1)) * 32 + ech] = h;
        }
    }
#undef LRU_DMA
#undef LRU_LOADW
    asm volatile("s_waitcnt vmcnt(0)" ::: "memory"); __syncthreads();
}
struct SchedMemKV { int G, c; const char* MN; const char* WK; const char* WV; unsigned char* ws;
                __device__ __forceinline__ bool next(int i, pg8::Unit& u) const { const int idx = i * G + c; if (idx >= 64) return false; u.sub = 0;
                    if (idx < 32) { u.pm = idx >> 3; u.pn = idx & 7; u.a = MN + (size_t)u.pm * 256 * DM * 2; u.b = WK + (size_t)u.pn * 256 * DM * 2; }
                    else { const int j = idx - 32; u.pm = 8 + (j >> 2); u.pn = j & 3; u.a = WV + (size_t)(j >> 2) * 256 * DM * 2; u.b = MN + (size_t)u.pn * 256 * DM * 2; }
                    return true; } };
              struct EpiMemKV { static constexpr bool AFTER_DRAIN = false, ACCUM2 = false; bf16_t* KO; bf16_t* VO;
                __device__ __forceinline__ void operator()(PG8_ACC, const pg8::Unit& u, int wr, int wc, int fr, int fq) const {
                    const bool isv = u.pm >= 8; const int ldc = isv ? MMEM : DM, pm = isv ? u.pm - 8 : u.pm;
                    bf16_t* base = (isv ? VO : KO) + (size_t)(pm * 256 + wr * 64 + fr) * ldc + u.pn * 256 + wc * 32 + 8 * fq;
#pragma unroll
                    for (int ai = 0; ai < 2; ++ai)
#pragma unroll
                        for (int m = 0; m < 4; ++m)
#pragma unroll
                            for (int bj = 0; bj < 2; ++bj) store8_bf16(base + (size_t)(ai * 128 + m * 16) * ldc + bj * 128, acc[ai][bj][m][0], acc[ai][bj][m][1]); } };
            struct SchedX2 { int G, c; const char* P; const char* VT;
                __device__ __forceinline__ bool next(int i, pg8::Unit& u) const { const int idx = i * G + c; if (idx >= 512) return false;
                    const int b = idx >> 7, qb = (idx >> 3) & 15, h = (idx >> 1) & 3, nt = idx & 1; u.pm = b * 16 + qb; u.pn = h * 2 + nt; u.sub = 0;
                    u.a = P + ((size_t)(b * SEQ + qb * 256) * 1024 + h * 256) * 2; u.b = VT + ((size_t)(h * 512 + nt * 256) * MMEM + b * NMEM) * 2; return true; } };

__global__ void __launch_bounds__(512, 2) hybrid_fwd(Args kargs) {
    extern __shared__ __attribute__((aligned(16))) unsigned char lds_raw[];
    LAS unsigned char* lds = (LAS unsigned char*)lds_raw;
    cg::grid_group grid = cg::this_grid();
    const int ph_lo = kargs.ph_lo, ph_hi = kargs.ph_hi;
    volatile LAS unsigned* bar_st = (volatile LAS unsigned*)(lds + LDS_BYTES - 64);
    if (threadIdx.x == 0) { bar_st[0] = 0u; bar_st[1] = 0u; if (ph_hi - ph_lo > 1) (void)xb_add((unsigned*)(kargs.ws + WS_BAR) + XB_XCNT(xb_xcc_id()), 1u); }
    __syncthreads();
    const int wave0 = __builtin_amdgcn_readfirstlane(threadIdx.x >> 6);
    const int st_hi = ph_hi + ((PROBE_Q >= 0 && ph_hi > PROBE_Q) ? PROBE_N : 0);
    for (int st = ph_lo; st < st_hi; ++st) {
        const bool dmy = (PROBE_Q >= 0) && st > PROBE_Q && st <= PROBE_Q + PROBE_N;
        const int ph = (PROBE_Q >= 0 && st > PROBE_Q) ? (dmy ? PROBE_Q : st - PROBE_N) : st;
        KArgs args = (KArgs)__builtin_amdgcn_kernarg_segment_ptr();
        asm volatile("" : "+s"(args));
        int wave = wave0; asm volatile("" : "+s"(wave));
        int bx = blockIdx.x; asm volatile("" : "+s"(bx));
        const int G = gridDim.x;
        const int vcu = (G % 8 == 0) ? (bx % 8) * (G / 8) + bx / 8 : bx;
        const int gw = vcu * 8 + wave, NGW = G * 8;
#define TID() (wave * 64 + CUR_LANE())
        unsigned char* ws = args->ws;
        u64* rowss = (u64*)(ws + WS_ROWSS);
        bf16_t* XB = (bf16_t*)(ws + WS_XB);
        float* xres = args->out;
        const int l = ph / NPH_LAYER, q = (ph == NPH - 1) ? 99 : ph % NPH_LAYER;
        unsigned char* wl = ws + WS_W;
        if (PHM(0) && q == 0) {
            const int lane = CUR_LANE();
            LAS float* scr = (LAS float*)(lds + wave * 16640);
            constexpr int I_IN = (DM / 64) * (NIN / 64), I_SQ = (DM / 64) * (DM / 64), I_KV = (DM / 64) * (2 * DM / 64), I_UP = (DM / 64) * (FF / 64), I_DN = I_UP, I_LRU = 2 * 2 * 16 * 4;
            constexpr int NITEMS = I_IN + 5 * I_SQ + I_KV + I_UP + I_DN + I_LRU;
            const size_t sq = (size_t)DM * DM;
            for (int it = gw; it < NITEMS; it += NGW) {
                int r = it;
                if (r < I_IN) { cvt_tile(args->in[IN_WIN] + (size_t)l * DM * NIN, NIN, (bf16_t*)(wl + W_IN), DM, args->in[IN_MIXG] + l * DM, 1.f, scr, r, lane); continue; } r -= I_IN;
                if (r < I_SQ) { cvt_tile(args->in[IN_WA] + l * sq, DM, (bf16_t*)(wl + W_A), DM, nullptr, 1.f, scr, r, lane); continue; } r -= I_SQ;
                if (r < I_SQ) { cvt_tile(args->in[IN_WR] + l * sq, DM, (bf16_t*)(wl + W_R), DM, nullptr, 1.f, scr, r, lane); continue; } r -= I_SQ;
                if (r < I_SQ) { cvt_tile(args->in[IN_WMIX] + l * sq, DM, (bf16_t*)(wl + W_MIX), DM, nullptr, 1.f, scr, r, lane); continue; } r -= I_SQ;
                if (r < I_SQ) { cvt_tile(args->in[IN_WXQ] + l * sq, DM, (bf16_t*)(wl + W_XQ), DM, args->in[IN_CROSSG] + l * DM, 0.044194173824159216f, scr, r, lane); continue; } r -= I_SQ;
                if (r < I_SQ) { cvt_tile(args->in[IN_WXO] + l * sq, DM, (bf16_t*)(wl + W_XO), DM, nullptr, 1.f, scr, r, lane); continue; } r -= I_SQ;
                if (r < I_KV) { cvt_tile(args->in[IN_WXKV] + l * 2 * sq, 2 * DM, (bf16_t*)(wl + W_XKV), DM, nullptr, 1.f, scr, r, lane); continue; } r -= I_KV;
                if (r < I_UP) { cvt_tile(args->in[IN_WUP] + (size_t)l * DM * FF, FF, (bf16_t*)(wl + W_UP), DM, args->in[IN_MLPG] + l * DM, 1.f, scr, r, lane); continue; } r -= I_UP;
                if (r < I_DN) { cvt_tile(args->in[IN_WDOWN] + (size_t)l * DM * FF, DM, (bf16_t*)(wl + W_DOWN), FF, nullptr, 1.f, scr, r, lane); continue; } r -= I_DN;
                { const int mat = r >> 7, rr = r & 127, dn = rr >> 2, t4 = rr & 3;
                  const float* src = args->in[mat ? IN_LWI : IN_LWR] + ((size_t)(l * 2) * 16 + dn) * 16384;
                  cvt_tile(src, 128, (bf16_t*)(wl + W_LRU) + ((size_t)mat * 32 + dn) * 16384, 128, nullptr, 1.f, scr, t4, lane); }
            }
            for (int m = gw; m < MMEM; m += NGW) { const f32x4* xr = (const f32x4*)(args->in[IN_MEM] + (size_t)m * DM) + lane; const f32x4* gr = (const f32x4*)(args->in[IN_MEMG] + l * DM) + lane;
                f32x4 v[8]; float s = 0.f;
#pragma unroll
                for (int j = 0; j < 8; ++j) { v[j] = xr[64 * j]; s += (v[j].x * v[j].x + v[j].y * v[j].y) + (v[j].z * v[j].z + v[j].w * v[j].w); }
                const float rs = __builtin_amdgcn_rsqf(wave_sum(s) * (1.f / DM) + EPS);
                u32x2* o8 = (u32x2*)((bf16_t*)(ws + WS_MN) + (size_t)m * DM) + lane;
#pragma unroll
                for (int j = 0; j < 8; ++j) { const f32x4 g = gr[64 * j]; u32x2 o; o.x = cvt_pk_bf16(v[j].x * rs * g.x, v[j].y * rs * g.y); o.y = cvt_pk_bf16(v[j].z * rs * g.z, v[j].w * rs * g.w); o8[64 * j] = o; } }
            if (l == 0) {
                for (int m = gw; m < MT; m += NGW) { const f32x4* xr = (const f32x4*)(args->in[IN_X] + (size_t)m * DM) + lane;
                    f32x4 v[8]; float s = 0.f;
#pragma unroll
                    for (int j = 0; j < 8; ++j) { v[j] = xr[64 * j]; s += (v[j].x * v[j].x + v[j].y * v[j].y) + (v[j].z * v[j].z + v[j].w * v[j].w); }
                    s = wave_sum(s); if (lane == 0) rowss[m] = f_to_ss(s);
                    u32x2* o8 = (u32x2*)(XB + (size_t)m * DM) + lane;
#pragma unroll
                    for (int j = 0; j < 8; ++j) { u32x2 o; o.x = cvt_pk_bf16(v[j].x, v[j].y); o.y = cvt_pk_bf16(v[j].z, v[j].w); o8[64 * j] = o; } }
                const int gt = bx * 512 + wave * 64 + lane;
                if (gt < 2048) { const int pos = gt >> 5, i = gt & 31; const float inv = __builtin_amdgcn_exp2f(-(float)i * (13.287712379549449f / 32.0f));
                    const float rev = (float)pos * inv * 0.15915494309189535f; float* T = (float*)(ws + WS_ROPE) + pos * 64;
                    T[i] = __builtin_amdgcn_cosf(rev); T[32 + i] = __builtin_amdgcn_sinf(rev); }
            }
        } else if (PHM(1) && (q == 1)) {
            pg8::SchedPlain S; S.o.init(MT, NIN, G, bx); S.A = (const char*)XB; S.B = (const char*)(wl + W_IN); S.tA = (size_t)256 * DM * 2; S.tB = (size_t)256 * DM * 2;
            pg8::EpiG1 E{ws, rowss + (size_t)(3 * l) * MT};
            pg8::gemm_phase<pg8::EpiG1, pg8::SchedPlain, true>(lds, TID(), DM, DM, DM, S, E);
        } else if (PHM(2) && (q == 2)) {
            if (PHM(13) && (!dmy || (PROBE_SUB & 1))) {
              SchedMemKV S{G, bx, (const char*)(ws + WS_MN), (const char*)(wl + W_XKV), (const char*)(wl + W_XKV + (size_t)DM * DM * 2), ws};
              EpiMemKV E{(bf16_t*)(ws + WS_MEMK), (bf16_t*)(ws + WS_MEMVT)};
              pg8::gemm_phase<EpiMemKV, SchedMemKV, true>(lds, TID(), DM, DM, DM, S, E); }
            __syncthreads();
            const int nsk = (G >= 128) ? 64 : 0;
            const int tgw = (bx - nsk) * 8 + wave, TNGW = (G - nsk) * 8;
            if (PHM(12) && !dmy && bx >= nsk) {
                const int lane = CUR_LANE(), cgp = lane & 15, tq = lane >> 4;
                const bf16_t* U = (const bf16_t*)(ws + WS_U); bf16_t* UFo = (bf16_t*)(ws + WS_UF);
                for (int it = tgw; it < (MT / 16) * 16; it += TNGW) { const int nb = it & 15, r0 = (it >> 4) * 16 + 4 * tq, cch = nb * 128 + cgp * 8, tl = (r0 & (SEQ - 1)) - 2;
                    const float* cw = args->in[IN_CONVW] + (size_t)l * 4 * DM + cch; const float* cb = args->in[IN_CONVB] + (size_t)l * DM + cch;
                    f32x4 cw0[4], cw1[4];
#pragma unroll
                    for (int t = 0; t < 4; ++t) { cw0[t] = *(const f32x4*)(cw + t * DM); cw1[t] = *(const f32x4*)(cw + t * DM + 4); }
                    const f32x4 cb0 = *(const f32x4*)cb, cb1 = *(const f32x4*)(cb + 4);
                    u32x4 ur[7];
#pragma unroll
                    for (int j = 0; j < 7; ++j) ur[j] = ((unsigned)(tl + j) < (unsigned)SEQ) ? *(const u32x4*)(U + (size_t)(r0 - 2 + j) * DM + cch) : (u32x4){0u, 0u, 0u, 0u};
                    f32x4 o0[4], o1[4];
#pragma unroll
                    for (int i = 0; i < 4; ++i) { o0[i] = cb0; o1[i] = cb1; }
#pragma unroll
                    for (int j = 0; j < 7; ++j) { const u32x4 q4 = ur[j]; const f32x4 r0v = {bf_lo(q4.x), bf_hi(q4.x), bf_lo(q4.y), bf_hi(q4.y)}, r1v = {bf_lo(q4.z), bf_hi(q4.z), bf_lo(q4.w), bf_hi(q4.w)};
#pragma unroll
                        for (int i = 0; i < 4; ++i) { const int tap = j - i; if (tap >= 0 && tap < 4) { o0[i] += r0v * cw0[tap]; o1[i] += r1v * cw1[tap]; } } }
#pragma unroll
                    for (int i = 0; i < 4; ++i) store8_bf16(UFo + (size_t)(r0 + i) * DM + cch, o0[i], o1[i]); }
            }
            if (PHM(12) && !dmy && bx >= nsk) {
                const int lane = CUR_LANE();
                const int j = lane & 7, half = j >> 2, c4 = j & 3; const float* T = (const float*)(ws + WS_ROPE);
                bf16_t* Kp = (bf16_t*)(ws + WS_K);
                for (int v = tgw * 8 + (lane >> 3); v < MT * 4; v += TNGW * 8) { const int m = v >> 2, hh = v & 3;
                    bf16_t* p = Kp + (size_t)m * 512 + hh * 128;
                    const float* g = args->in[IN_KG] + l * 128 + 64 * half + 8 * c4;
                    p += 64 * half + 8 * c4;
                    const u32x4 ua = *(const u32x4*)p, ub = *(const u32x4*)(p + 32);
                    float a[8], bb[8];
#pragma unroll
                    for (int e = 0; e < 4; ++e) { a[2 * e] = bf_lo(ua[e]); a[2 * e + 1] = bf_hi(ua[e]); bb[2 * e] = bf_lo(ub[e]); bb[2 * e + 1] = bf_hi(ub[e]); }
                    float ss = 0.f;
#pragma unroll
                    for (int e = 0; e < 8; ++e) ss += a[e] * a[e] + bb[e] * bb[e];
                    ss += shx(ss, 1); ss += shx(ss, 2); ss += shx(ss, 4);
                    const float rs = __builtin_amdgcn_rsqf(ss * (1.f / 128.f) + EPS);
                    const int t = m & (SEQ - 1), pos = half ? (t & 63) : (t >> 6);
                    const float* Tc = T + pos * 64 + 8 * c4;
                    float oa[8], ob[8];
#pragma unroll
                    for (int e = 0; e < 8; ++e) { const float x1 = a[e] * rs * g[e], x2 = bb[e] * rs * g[32 + e], cs = Tc[e], sn = Tc[32 + e]; oa[e] = x1 * cs - x2 * sn; ob[e] = x2 * cs + x1 * sn; }
                    u32x4 wa, wb;
#pragma unroll
                    for (int e = 0; e < 4; ++e) { wa[e] = cvt_pk_bf16(oa[2 * e], oa[2 * e + 1]); wb[e] = cvt_pk_bf16(ob[2 * e], ob[2 * e + 1]); }
                    *(u32x4*)p = wa; *(u32x4*)(p + 32) = wb; }
            }
        } else if (PHM(3) && (q == 3)) {
            if (PHM(10) && (!dmy || (PROBE_SUB & 2))) for (int u = vcu; u < 256; u += G) { lru_sweep3_item(lds, args, l, u, TID(), dmy ? PROBE_ABL : 0, wave, (bf16_t*)(ws + (dmy ? WS_U : WS_Y))); __syncthreads(); }
            if (PHM(11) && (!dmy || (PROBE_SUB & 1))) for (int u = vcu; u < 1024; u += G) { const int rnd = u / G, xcd_ = vcu >> 5; const bool own = (G == 256);
                const int grp = own ? xcd_ * 2 + (rnd >> 1) : (u >> 6), idx = own ? (rnd & 1) * 32 + (vcu & 31) : (u & 63), b = grp >> 2, kvh = grp & 3, hq = kvh * 4 + (idx >> 4), qb = idx & 15;
                bf16_t* Qb = (bf16_t*)(ws + WS_Q) + ((size_t)(b * SEQ + qb * 256)) * 2048 + hq * 128;
                const bf16_t* Kh = (const bf16_t*)(ws + WS_K) + (size_t)b * SEQ * 512 + kvh * 128; const bf16_t* Vh = (const bf16_t*)(ws + WS_V) + (size_t)b * SEQ * 512 + kvh * 128;
                att::attn_dense_body(Qb, Kh, Vh, dmy ? Qb + (WS_DUMMY - WS_Q) / 2 : Qb, SEQ, (char*)lds_raw, TID(), args->in[IN_QG] + l * 128, (const float*)(ws + WS_ROPE), qb * 256);
                __syncthreads(); }
        } else if (PHM(4) && (q == 4)) {
            pg8::SchedDual S; S.o.init(MT, DM, G, bx); S.A = (const char*)(ws + WS_Q); S.B = (const char*)(wl + W_A); S.A2 = (const char*)(ws + WS_Y); S.B2 = (const char*)(wl + W_R);
            S.tA = (size_t)256 * DM * 2; S.tB = (size_t)256 * DM * 2;
            pg8::EpiGate E{(const bf16_t*)(ws + WS_GA), (const bf16_t*)(ws + WS_GR), (bf16_t*)(ws + WS_MERGED)};
            pg8::gemm_phase<pg8::EpiGate, pg8::SchedDual, true>(lds, TID(), DM, DM, DM, S, E);
        } else if (PHM(5) && (q == 5 || q == 9 || q == 11)) {
            pg8::SchedPlain S; S.o.init(MT, DM, G, bx); S.tB = (size_t)256 * DM * 2; int K = DM;
            if (q == 5) { S.A = (const char*)(ws + WS_MERGED); S.B = (const char*)(wl + W_MIX); S.tA = (size_t)256 * DM * 2; }
            else if (q == 9) { S.A = (const char*)(ws + WS_XO); S.B = (const char*)(wl + W_XO); S.tA = (size_t)256 * DM * 2; }
            else { S.A = (const char*)(ws + WS_H); S.B = (const char*)(wl + W_DOWN); S.tA = (size_t)256 * FF * 2; S.tB = (size_t)256 * FF * 2; K = FF; }
            const int ridx = (q == 5) ? 3 * l + 1 : (q == 9) ? 3 * l + 2 : 3 * l + 3;
            pg8::EpiRes E{XB, (q == 11 && l == 1) ? xres : nullptr, rowss + (size_t)ridx * MT};
            pg8::gemm_phase<pg8::EpiRes, pg8::SchedPlain, false>(lds, TID(), K, K, K, S, E);
        } else if (PHM(6) && (q == 6 || q == 10)) {
            pg8::SchedPlain S; S.A = (const char*)XB; S.tA = (size_t)256 * DM * 2; S.tB = (size_t)256 * DM * 2;
            S.o.init(MT, q == 6 ? DM : FF, G, bx); S.B = (const char*)(wl + (q == 6 ? W_XQ : W_UP));
            pg8::EpiRow1 E{(bf16_t*)(ws + (q == 6 ? WS_XQ : WS_H)), q == 6 ? DM : FF, rowss + (size_t)(3 * l + (q == 6 ? 1 : 2)) * MT, q == 6 ? 0 : 1};
            pg8::gemm_phase<pg8::EpiRow1, pg8::SchedPlain, true>(lds, TID(), DM, DM, DM, S, E);
        } else if (PHM(7) && (q == 7)) {
            for (int u = vcu; u < 256; u += G) { const int b = u >> 6, h = (u >> 4) & 3, qb = u & 15;
                pg8::SchedOne S; S.u.pm = b * 16 + qb; S.u.pn = h; S.u.sub = 0;
                S.u.a = (const char*)(ws + WS_XQ) + ((size_t)(b * SEQ + qb * 256) * DM + h * 512) * 2; S.u.b = (const char*)(ws + WS_MEMK) + ((size_t)(b * NMEM) * DM + h * 512) * 2;
                pg8::EpiSoftmax E{(bf16_t*)(ws + WS_P), 1024};
                pg8::gemm_phase<pg8::EpiSoftmax, pg8::SchedOne, false>(lds, TID(), 512, DM, DM, S, E);
                __syncthreads(); }
        } else if (PHM(8) && (q == 8)) {
            SchedX2 S{G, vcu, (const char*)(ws + WS_P), (const char*)(ws + WS_MEMVT)};
            pg8::EpiPlain E{(bf16_t*)(ws + WS_XO), DM};
            pg8::gemm_phase<pg8::EpiPlain, SchedX2, true>(lds, TID(), 256, 1024, MMEM, S, E);
        } else if (PHM(9) && (q == 99)) {
            const int lane = CUR_LANE();
            const u64* rs6 = rowss + (size_t)6 * MT;
            for (int m = gw; m < MT; m += NGW) { f32x4* xr = (f32x4*)(xres + (size_t)m * DM) + lane; const f32x4* gr = (const f32x4*)args->in[IN_FING] + lane;
                const float rs = __builtin_amdgcn_rsqf(ss_to_f(rs6[m]) * (1.f / DM) + EPS);
#pragma unroll
                for (int j = 0; j < 8; ++j) { const f32x4 v = xr[64 * j], g = gr[64 * j]; xr[64 * j] = v * rs * g; } }
        }
        if (st + 1 < st_hi) {
            if (ph_hi > 1000000) grid.sync();
            xcd_barrier((unsigned*)(ws + WS_BAR), bar_st);
            for (int e = 0; e < PROBE_SYNC; ++e) xcd_barrier((unsigned*)(ws + WS_BAR), bar_st); }
    }
}

extern "C" void kernel_launch(void* const* d_in, const int* in_sizes, int n_in, void* d_out, int out_size, void* d_ws, size_t ws_size, hipStream_t stream) {
    static int grid = 0;
    if (grid == 0) {
        if (n_in != 25 || in_sizes[0] != MT * DM || out_size != MT * DM || ws_size < WS_END) { fprintf(stderr, "kernel_launch: unexpected shapes (n_in %d, ws %zu, need %zu)\n", n_in, ws_size, (size_t)WS_END); grid = -1; return; }
        int dev = 0, cus = 0, per_cu = 0;
        hipGetDevice(&dev); hipDeviceGetAttribute(&cus, hipDeviceAttributeMultiprocessorCount, dev);
        if (hipFuncSetAttribute((const void*)hybrid_fwd, hipFuncAttributeMaxDynamicSharedMemorySize, LDS_BYTES) != hipSuccess) { fprintf(stderr, "kernel_launch: hipFuncSetAttribute failed\n"); grid = -1; return; }
        if (hipOccupancyMaxActiveBlocksPerMultiprocessor(&per_cu, (const void*)hybrid_fwd, 512, LDS_BYTES) != hipSuccess || per_cu < 1) { fprintf(stderr, "kernel_launch: occupancy query says %d\n", per_cu); per_cu = 1; }
        (void)hipGetLastError();
        grid = cus;
    }
    if (grid < 0) return;
    hipMemsetAsync((char*)d_ws + WS_ROWSS, 0, CTL_BYTES, stream);
    Args a{};
    for (int i = 0; i < 25; ++i) a.in[i] = (const float*)d_in[i];
    a.out = (float*)d_out; a.ws = (unsigned char*)d_ws;
#if MK_ONE_LAUNCH
    a.ph_lo = 0; a.ph_hi = NPH;
    void* kargs[] = {&a};
    hipError_t e = hipLaunchCooperativeKernel((const void*)hybrid_fwd, dim3(grid), dim3(512), kargs, LDS_BYTES, stream);
    if (e != hipSuccess) fprintf(stderr, "kernel_launch: cooperative launch failed: %s (grid %d)\n", hipGetErrorString(e), grid);
#else
    for (int p = 0; p < NPH; ++p) { a.ph_lo = p; a.ph_hi = p + 1; hipLaunchKernelGGL(hybrid_fwd, dim3(grid), dim3(512), LDS_BYTES, stream, a); }
#endif
}
```
